# Optimizing an MI355X kernel written in HIP

```python
import jax
import jax.numpy as jnp
from jax import lax
import numpy as np

D_MODEL = 1024
BATCH = 4
SEQ = 8192
DEPTH = 2

GRID_W = 64
CTX_LEN = 256
N_HEADS = 8
QK_NOPE = 64
QK_ROPE = 32
V_DIM = 64
Q_LORA = 256
KV_LORA = 128
ROPE_THETA = 10000.0
ATTN_SCALE = (QK_NOPE + QK_ROPE) ** -0.5
Q_BLOCK = 128
CONV_WIDTH = 512
CONV_K = 3
N_EXPERTS = 32
TOP_K = 4
D_FF = D_MODEL
SWIGLU_LIMIT = 7.0
SWIGLU_ALPHA = 1.702
NORM_EPS = 1e-6
DEEPNORM_ALPHA = (2 * DEPTH) ** 0.25
DEEPNORM_BETA = (8 * DEPTH) ** -0.25

OFF_QA = 0
OFF_KV = OFF_QA + Q_LORA
OFF_KR = OFF_KV + KV_LORA
OFF_CX = OFF_KR + QK_ROPE
OFF_CB = OFF_CX + CONV_WIDTH
OFF_CC = OFF_CB + CONV_WIDTH
OFF_GA = OFF_CC + CONV_WIDTH
OFF_GB = OFF_GA + D_MODEL
IN_WIDTH = OFF_GB + D_MODEL

kernel_name = "hybrid_mla_shortconv_moe_dit"


def layer_norm(x, g, b):
    xf = x.astype(jnp.float32)
    mu = jnp.mean(xf, axis=-1, keepdims=True)
    var = jnp.mean(jnp.square(xf - mu), axis=-1, keepdims=True)
    return ((xf - mu) * lax.rsqrt(var + NORM_EPS) * g + b).astype(x.dtype)


def rms_norm(x, g):
    xf = x.astype(jnp.float32)
    return (xf * lax.rsqrt(jnp.mean(jnp.square(xf), axis=-1, keepdims=True) + NORM_EPS) * g).astype(x.dtype)


def axial_rope_tables(n, dtype):
    n_rows = n // GRID_W
    row = jnp.broadcast_to(jnp.arange(n_rows, dtype=jnp.float32)[:, None], (n_rows, GRID_W)).reshape(-1)
    col = jnp.broadcast_to(jnp.arange(GRID_W, dtype=jnp.float32)[None, :], (n_rows, GRID_W)).reshape(-1)
    half = QK_ROPE // 2
    freqs = ROPE_THETA ** (-jnp.arange(0, half, 2, dtype=jnp.float32) / half)
    ang_r = row[:, None] * freqs
    ang_c = col[:, None] * freqs
    ang = jnp.concatenate([ang_r, ang_r, ang_c, ang_c], axis=-1)
    return jnp.cos(ang).astype(dtype), jnp.sin(ang).astype(dtype)


def rotate_axial(x, cos, sin):
    x1, x2, x3, x4 = jnp.split(x, 4, axis=-1)
    rot = jnp.concatenate([-x2, x1, -x4, x3], axis=-1)
    return x * cos + rot * sin


def mla_queries(q_a, q_norm, w_uq):
    q = rms_norm(q_a, q_norm) @ w_uq
    q = q.reshape(*q_a.shape[:-1], N_HEADS, QK_NOPE + QK_ROPE)
    return q[..., :QK_NOPE], q[..., QK_NOPE:]


def mla_kv(kv_a, kv_norm, w_uk, w_uv):
    ckv = rms_norm(kv_a, kv_norm)
    shp = kv_a.shape[:-1]
    return (ckv @ w_uk).reshape(*shp, N_HEADS, QK_NOPE), (ckv @ w_uv).reshape(*shp, N_HEADS, V_DIM)


def mla_attend(q_nope, q_rope, k_nope, k_rope, v):
    s = jnp.einsum('bqhd,bkhd->bhqk', q_nope, k_nope, preferred_element_type=jnp.float32)
    s = s + jnp.einsum('bqhr,bkr->bhqk', q_rope, k_rope, preferred_element_type=jnp.float32)
    p = jax.nn.softmax(s * ATTN_SCALE, axis=-1)
    return jnp.einsum('bhqk,bkhd->bqhd', p.astype(v.dtype), v)


def latent_attention(q_nope, q_rope, k_nope, k_rope, v):
    b, n = q_nope.shape[:2]
    nb = n // Q_BLOCK

    def blocks(t):
        return jnp.moveaxis(t.reshape(b, nb, Q_BLOCK, *t.shape[2:]), 1, 0)

    out = lax.map(lambda qs: mla_attend(qs[0], qs[1], k_nope, k_rope, v), (blocks(q_nope), blocks(q_rope)))
    return jnp.moveaxis(out, 0, 1).reshape(b, n, N_HEADS * V_DIM)


def short_conv(u, b_gate, c_gate, w, bias):
    n = u.shape[1]
    pad = CONV_K // 2
    z = jnp.pad(c_gate * u, ((0, 0), (pad, pad), (0, 0)))
    y = sum(z[:, k:k + n] * w[k] for k in range(CONV_K)) + bias
    return b_gate * y


def merge_branches(p, attn, conv_w, conv_b, w_oa, w_ob, w_o):
    conv = short_conv(p[..., OFF_CX:OFF_CB], p[..., OFF_CB:OFF_CC], p[..., OFF_CC:OFF_GA], conv_w, conv_b)
    y_a = attn @ w_oa
    y_b = conv @ w_ob
    merged = jax.nn.sigmoid(p[..., OFF_GA:OFF_GB]) * y_a + jax.nn.sigmoid(p[..., OFF_GB:IN_WIDTH]) * y_b
    return merged @ w_o


def token_mixer(h, hc, cos, sin, with_ctx_out, w_in, b_in, q_norm, kv_norm, w_uq, w_uk, w_uv,
                w_oa, conv_w, conv_b, w_ob, w_o):
    p = h @ w_in + b_in
    if with_ctx_out:
        pc = hc @ w_in + b_in
        kv_c = pc[..., OFF_KV:OFF_CX]
    else:
        kv_c = hc @ w_in[:, OFF_KV:OFF_CX] + b_in[OFF_KV:OFF_CX]
    kc_nope, vc = mla_kv(kv_c[..., :KV_LORA], kv_norm, w_uk, w_uv)
    kc_rope = kv_c[..., KV_LORA:]
    k_nope, v = mla_kv(p[..., OFF_KV:OFF_KR], kv_norm, w_uk, w_uv)
    k_rope = rotate_axial(p[..., OFF_KR:OFF_CX], cos, sin)
    q_nope, q_rope = mla_queries(p[..., OFF_QA:OFF_KV], q_norm, w_uq)
    q_rope = rotate_axial(q_rope, cos[:, None], sin[:, None])
    attn = latent_attention(q_nope, q_rope,
                            jnp.concatenate([kc_nope, k_nope], axis=1),
                            jnp.concatenate([kc_rope, k_rope], axis=1),
                            jnp.concatenate([vc, v], axis=1))
    y = merge_branches(p, attn, conv_w, conv_b, w_oa, w_ob, w_o)
    if not with_ctx_out:
        return y, None
    qc_nope, qc_rope = mla_queries(pc[..., OFF_QA:OFF_KV], q_norm, w_uq)
    attn_c = mla_attend(qc_nope, qc_rope, kc_nope, kc_rope, vc)
    attn_c = attn_c.reshape(*attn_c.shape[:2], N_HEADS * V_DIM)
    y_c = merge_branches(pc, attn_c, conv_w, conv_b, w_oa, w_ob, w_o)
    return y, y_c


def moe_ffn(t, w_router, b_router, w_gu, b_gu, w_down, b_down):
    logits = jnp.dot(t, w_router, preferred_element_type=jnp.float32) + b_router.astype(jnp.float32)
    top_logit, top_idx = lax.top_k(logits, TOP_K)
    top_p = jax.nn.softmax(top_logit, axis=-1)
    gates = jnp.einsum('tk,tke->te', top_p, jax.nn.one_hot(top_idx, N_EXPERTS, dtype=jnp.float32)).astype(t.dtype)

    def expert(acc, xs):
        wgu, bgu, wd, bd, g = xs
        gu = t @ wgu + bgu
        gate = jnp.minimum(gu[:, :D_FF], SWIGLU_LIMIT)
        up = jnp.clip(gu[:, D_FF:], -SWIGLU_LIMIT, SWIGLU_LIMIT)
        y = ((up + 1.0) * gate * jax.nn.sigmoid(SWIGLU_ALPHA * gate)) @ wd + bd
        return acc + g[:, None] * y, None

    out, _ = lax.scan(expert, jnp.zeros_like(t), (w_gu, b_gu, w_down, b_down, gates.T))
    return out


def setup_inputs(seed: int = 0) -> dict:
    key = jax.random.key(seed)
    ks = jax.random.split(key, 32)
    f32 = jnp.float32
    beta = DEEPNORM_BETA

    def nrm(k, shape, scale):
        return jax.random.normal(k, shape, f32) * scale

    L = DEPTH
    return {
        'x': nrm(ks[0], (BATCH, SEQ, D_MODEL), 1.0),
        'c': nrm(ks[1], (BATCH, D_MODEL), 1.0),
        'ctx': nrm(ks[2], (BATCH, CTX_LEN, D_MODEL), 1.0),
        'c_ctx': nrm(ks[3], (D_MODEL,), 1.0),
        'w_ada': nrm(ks[4], (L, D_MODEL, 6 * D_MODEL), 0.5 * D_MODEL ** -0.5),
        'b_ada': nrm(ks[5], (L, 6 * D_MODEL), 0.02),
        'w_in': nrm(ks[6], (L, D_MODEL, IN_WIDTH), D_MODEL ** -0.5),
        'b_in': nrm(ks[7], (L, IN_WIDTH), 0.02),
        'q_norm': 1.0 + nrm(ks[8], (L, Q_LORA), 0.02),
        'kv_norm': 1.0 + nrm(ks[9], (L, KV_LORA), 0.02),
        'w_uq': nrm(ks[10], (L, Q_LORA, N_HEADS * (QK_NOPE + QK_ROPE)), Q_LORA ** -0.5),
        'w_uk': nrm(ks[11], (L, KV_LORA, N_HEADS * QK_NOPE), KV_LORA ** -0.5),
        'w_uv': nrm(ks[12], (L, KV_LORA, N_HEADS * V_DIM), beta * KV_LORA ** -0.5),
        'w_oa': nrm(ks[13], (L, N_HEADS * V_DIM, D_MODEL), beta * (N_HEADS * V_DIM) ** -0.5),
        'conv_w': nrm(ks[14], (L, CONV_K, CONV_WIDTH), CONV_K ** -0.5),
        'conv_b': nrm(ks[15], (L, CONV_WIDTH), 0.02),
        'w_ob': nrm(ks[16], (L, CONV_WIDTH, D_MODEL), beta * CONV_WIDTH ** -0.5),
        'w_o': nrm(ks[17], (L, D_MODEL, D_MODEL), beta * D_MODEL ** -0.5),
        'ln1_g': 1.0 + nrm(ks[18], (L, D_MODEL), 0.02),
        'ln1_b': nrm(ks[19], (L, D_MODEL), 0.02),
        'ln2_g': 1.0 + nrm(ks[20], (L, D_MODEL), 0.02),
        'ln2_b': nrm(ks[21], (L, D_MODEL), 0.02),
        'w_router': nrm(ks[22], (L, D_MODEL, N_EXPERTS), D_MODEL ** -0.5),
        'b_router': nrm(ks[23], (L, N_EXPERTS), 0.01),
        'w_gu': nrm(ks[24], (L, N_EXPERTS, D_MODEL, 2 * D_FF), beta * D_MODEL ** -0.5),
        'b_gu': nrm(ks[25], (L, N_EXPERTS, 2 * D_FF), 0.02),
        'w_down': nrm(ks[26], (L, N_EXPERTS, D_FF, D_MODEL), beta * D_FF ** -0.5),
        'b_down': nrm(ks[27], (L, N_EXPERTS, D_MODEL), 0.02),
    }


def reference(x, c, ctx, c_ctx, w_ada, b_ada, w_in, b_in, q_norm, kv_norm, w_uq, w_uk, w_uv, w_oa,
              conv_w, conv_b, w_ob, w_o, ln1_g, ln1_b, ln2_g, ln2_b, w_router, b_router,
              w_gu, b_gu, w_down, b_down):
    b, n, d = x.shape
    cos, sin = axial_rope_tables(n, x.dtype)
    silu_c = jax.nn.silu(c)
    silu_cc = jax.nn.silu(c_ctx)
    alpha = DEEPNORM_ALPHA
    for l in range(DEPTH):
        update_ctx = l < DEPTH - 1
        mod = silu_c @ w_ada[l] + b_ada[l]
        mod_c = silu_cc @ w_ada[l] + b_ada[l]
        sh1, sc1, g1, sh2, sc2, g2 = jnp.split(mod[:, None, :], 6, axis=-1)
        sh1c, sc1c, g1c, sh2c, sc2c, g2c = jnp.split(mod_c, 6)
        h = x * (1.0 + sc1) + sh1
        hc = ctx * (1.0 + sc1c) + sh1c
        y, y_c = token_mixer(h, hc, cos, sin, update_ctx, w_in[l], b_in[l], q_norm[l], kv_norm[l],
                             w_uq[l], w_uk[l], w_uv[l], w_oa[l], conv_w[l], conv_b[l], w_ob[l], w_o[l])
        x = layer_norm(alpha * x + g1 * y, ln1_g[l], ln1_b[l])
        if update_ctx:
            ctx = layer_norm(alpha * ctx + g1c * y_c, ln1_g[l], ln1_b[l])
        h = (x * (1.0 + sc2) + sh2).reshape(b * n, d)
        if update_ctx:
            hc = (ctx * (1.0 + sc2c) + sh2c).reshape(-1, d)
            f = moe_ffn(jnp.concatenate([h, hc], axis=0), w_router[l], b_router[l],
                        w_gu[l], b_gu[l], w_down[l], b_down[l])
            f_x = f[:b * n]
            ctx = layer_norm(alpha * ctx + g2c * f[b * n:].reshape(ctx.shape), ln2_g[l], ln2_b[l])
        else:
            f_x = moe_ffn(h, w_router[l], b_router[l], w_gu[l], b_gu[l], w_down[l], b_down[l])
        x = layer_norm(alpha * x + g2 * f_x.reshape(b, n, d), ln2_g[l], ln2_b[l])
    return x
```

```cpp
#include <hip/hip_runtime.h>
#include <hip/hip_cooperative_groups.h>
#include <cstdio>
namespace cg = cooperative_groups;

#define LAS __attribute__((address_space(3)))
typedef unsigned short bf16_t;
typedef short bf16x8 __attribute__((ext_vector_type(8)));
typedef short bf16x4 __attribute__((ext_vector_type(4)));
typedef float f32x4 __attribute__((ext_vector_type(4)));
typedef float f32x16 __attribute__((ext_vector_type(16)));
typedef float f32x8 __attribute__((ext_vector_type(8)));
typedef float f32x2 __attribute__((ext_vector_type(2)));
typedef unsigned u32x4 __attribute__((ext_vector_type(4)));
typedef unsigned u32x2 __attribute__((ext_vector_type(2)));

constexpr int D = 1024, NBATCH = 4, SEQ = 8192, CTXL = 256, RPB = SEQ + CTXL, MR = NBATCH * RPB;
constexpr int DEPTH = 2, NH = 8, INW = 4000, INWP = 4096, NEXP = 32;
constexpr int OFF_KV = 256, OFF_KR = 384, OFF_CX = 416, OFF_CB = 928, OFF_CC = 1440, OFF_GA = 1952, OFF_GB = 2976;
constexpr float NORM_EPS = 1e-6f, DN_ALPHA = 1.41421356237f, SW_LIMIT = 7.0f, SW_ALPHA = 1.702f;
constexpr float QSCALE = 0.10206207261596575f * 1.4426950408889634f;
constexpr int SLOT_CAP = 143360;
constexpr int NTHREADS = 512;
constexpr int LDS_BYTES = 156 * 1024, MISC_OFF = 128 * 1024, GTAB_OFF = MISC_OFF + 1024;

constexpr size_t WS_CTL = 0;
constexpr size_t WS_MOD = 4096;
constexpr size_t WS_ROPE = WS_MOD + (size_t)DEPTH * 5 * 6144 * 4;
constexpr size_t WS_RSQ = WS_ROPE + (size_t)SEQ * 16 * 8;
constexpr size_t WS_RSKV = WS_RSQ + (size_t)MR * 4;
constexpr size_t WS_RE = WS_RSKV + (size_t)MR * 4;
constexpr size_t WS_RPOS = WS_RE + (size_t)MR * 16;
constexpr size_t WS_RG = WS_RPOS + (size_t)MR * 16;
constexpr size_t WS_SLOTOF = WS_RG + (size_t)MR * 16;
constexpr size_t WS_GWS = WS_SLOTOF + (size_t)MR * 16;
constexpr size_t WS_ROWOFF = WS_GWS + (size_t)SLOT_CAP * 4;
constexpr size_t WS_WTIN = WS_ROWOFF + (size_t)SLOT_CAP * 4;
constexpr size_t WS_WTUQ = WS_WTIN + (size_t)DEPTH * INWP * 1024 * 2;
constexpr size_t WS_WTUKV = WS_WTUQ + (size_t)DEPTH * 768 * 256 * 2;
constexpr size_t WS_WTOAB = WS_WTUKV + (size_t)DEPTH * 1024 * 256 * 2;
constexpr size_t WS_WTO = WS_WTOAB + (size_t)DEPTH * 1024 * 1024 * 2;
constexpr size_t WS_WTGU = WS_WTO + (size_t)DEPTH * 1024 * 1024 * 2;
constexpr size_t WS_WTDN = WS_WTGU + (size_t)DEPTH * NEXP * 2048 * 1024 * 2;
constexpr size_t WS_HB = WS_WTDN + (size_t)DEPTH * NEXP * 1024 * 1024 * 2;
constexpr size_t WS_P = WS_HB + (size_t)MR * 1024 * 2;
constexpr size_t WS_Q = WS_P + (size_t)MR * INWP * 2;
constexpr size_t WS_KN = WS_Q + (size_t)MR * 768 * 2;
constexpr size_t WS_KR = WS_KN + (size_t)MR * 512 * 2;
constexpr size_t WS_VT = WS_KR + (size_t)MR * 32 * 2;
constexpr size_t WS_AC = WS_VT + (size_t)MR * 512 * 2;
constexpr size_t WS_MG = WS_AC + (size_t)MR * 1024 * 2;
constexpr size_t WS_RES = WS_MG + (size_t)MR * 1024 * 2;
constexpr size_t WS_AS = WS_RES + (size_t)MR * 1024 * 4;
constexpr size_t WS_ACT = WS_AS + (size_t)SLOT_CAP * 1024 * 2;
constexpr size_t WS_END = WS_ACT + (size_t)SLOT_CAP * 1024 * 2;

#ifndef PH
#define PH 0xffff
#endif
#ifndef DUP
#define DUP 0
#endif
#ifndef AMODE
#define AMODE 0
#endif
#define REP(k) for (int rep_ = 0; rep_ <= ((DUP >> (k)) & 1); ++rep_)
struct Args { const float* in[28]; float* out; unsigned char* ws; };

__device__ __forceinline__ int lane_id() { int l; asm volatile("v_mbcnt_lo_u32_b32 %0, -1, 0\n\tv_mbcnt_hi_u32_b32 %0, -1, %0" : "=v"(l)); return l; }
__device__ __forceinline__ int mk_tid(int wid_s) { return wid_s * 64 + lane_id(); }
template <int M> __device__ __forceinline__ float swz(float v) { return __int_as_float(__builtin_amdgcn_ds_swizzle(__float_as_int(v), (M << 10) | 0x1f)); }
__device__ __forceinline__ float shx32(float v, int lane) { return __int_as_float(__builtin_amdgcn_ds_bpermute((lane ^ 32) << 2, __float_as_int(v))); }
__device__ __forceinline__ void gsync(unsigned* bar, unsigned epoch, int wid_s) {
    asm volatile("s_waitcnt vmcnt(0)" ::: "memory");
    __syncthreads();
    if (wid_s == 0) {
        if (lane_id() == 0) {
            __builtin_amdgcn_fence(__ATOMIC_RELEASE, "agent");
            const unsigned per = gridDim.x >> 3;
            const unsigned old = __hip_atomic_fetch_add(bar + 32u * (1u + (blockIdx.x & 7u)), 1u, __ATOMIC_RELAXED, __HIP_MEMORY_SCOPE_AGENT);
            if (old + 1u == epoch * per) __hip_atomic_fetch_add(bar, 1u, __ATOMIC_RELAXED, __HIP_MEMORY_SCOPE_AGENT);
            while (__hip_atomic_load(bar, __ATOMIC_RELAXED, __HIP_MEMORY_SCOPE_AGENT) < epoch * 8u) __builtin_amdgcn_s_sleep(1);
            __builtin_amdgcn_fence(__ATOMIC_ACQUIRE, "agent");
        }
    }
    __syncthreads();
}
__device__ __forceinline__ unsigned pk_bf16(float lo, float hi) { unsigned r; asm("v_cvt_pk_bf16_f32 %0, %1, %2" : "=v"(r) : "v"(lo), "v"(hi)); return r; }
__device__ __forceinline__ float bf_lo(unsigned u) { return __uint_as_float(u << 16); }
__device__ __forceinline__ float bf_hi(unsigned u) { return __uint_as_float(u & 0xffff0000u); }
__device__ __forceinline__ float bf2f(bf16_t b) { return __uint_as_float(((unsigned)b) << 16); }
__device__ __forceinline__ float fexp2(float x) { return __builtin_amdgcn_exp2f(x); }
__device__ __forceinline__ float frcp(float x) { return __builtin_amdgcn_rcpf(x); }
__device__ __forceinline__ float sigmoidf_(float x) { return frcp(1.0f + fexp2(-1.4426950408889634f * x)); }
__device__ __forceinline__ float max3f(float a, float b, float c) { float d; asm("v_max3_f32 %0, %1, %2, %3" : "=v"(d) : "v"(a), "v"(b), "v"(c)); return d; }
__device__ __forceinline__ float wave_sum(float v, int lane) {
    v += shx32(v, lane); v += swz<16>(v); v += swz<8>(v); v += swz<4>(v); v += swz<2>(v); v += swz<1>(v);
    return v;
}

namespace pg8 {
constexpr int BM = 256, BK = 64, HALF = 128, HTB = HALF * BK * 2;
__device__ __forceinline__ int lds_byte(int r, int c) { const int st = (r >> 4) * 2 + (c >> 5), rr = r & 15, cc = c & 31, ob = rr * 64 + cc * 2; return st * 1024 + (ob ^ (((ob >> 9) & 1) << 5)); }
__device__ __forceinline__ void stage_rc(int b, int& R, int& C) { const int st = b / 1024, sb = b % 1024, swz = sb ^ (((sb >> 9) & 1) << 5); R = (st >> 1) * 16 + swz / 64; C = (st & 1) * 32 + (swz % 64) / 2; }
__device__ __forceinline__ int perm32(int rho) { const int n = rho >> 4, i = rho & 15; return 8 * (i >> 2) + 4 * n + (i & 3); }

struct Unit { const char* A; const char* B; int pm, pn, e; };

__device__ __forceinline__ bool unit_coords(unsigned L, int nM, int nN, int& pm, int& pn) {
    const unsigned total = (unsigned)nM * (unsigned)nN; if (L >= total) return false;
    const unsigned fullg = (unsigned)nM >> 3, full = fullg * 8u * (unsigned)nN;
    if (L < full) { const unsigned x = L & 7u, q = L >> 3; const unsigned qd = q / (unsigned)nN; pn = (int)(q - qd * (unsigned)nN); pm = (int)(qd * 8u + x); }
    else { const unsigned r = (unsigned)nM & 7u, Lp = L - full; const unsigned qd = Lp / r; pm = (int)(fullg * 8u + (Lp - qd * r)); pn = (int)qd; }
    return true;
}
struct SchedDense {
    const char* A; size_t a_tstep; const char* B; size_t b_tstep; int nM, nN, G, c, skipctx;
    __device__ __forceinline__ bool next(int i, Unit& u) const {
        int pm, pn; if (!unit_coords((unsigned)(i * G + c), nM, nN, pm, pn)) return false;
        if (skipctx == 1) pm += (pm >> 5) + 1;
        if (skipctx == 2) { pm = 0; pn = 0; }
        u.pm = pm; u.pn = pn; u.e = 0; u.A = A + (size_t)pm * a_tstep; u.B = B + (size_t)pn * b_tstep; return true;
    }
};
struct SchedQKV {
    const char* Aq; const char* Bq; const char* Akv; const char* Bkv; size_t a_tstep, b_tstep; int nMq, skipq, G, c;
    __device__ __forceinline__ bool next(int i, Unit& u) const {
        const unsigned L = (unsigned)(i * G + c), nQ = (unsigned)nMq * 3u;
        int pm, pn;
        if (L < nQ) { unit_coords(L, nMq, 3, pm, pn); if (skipq) pm += (pm >> 5) + 1; u.e = 0; u.A = Aq + (size_t)pm * a_tstep; u.B = Bq + (size_t)pn * b_tstep; }
        else { if (!unit_coords(L - nQ, MR / 256, 4, pm, pn)) return false; u.e = 1; u.A = Akv + (size_t)pm * a_tstep; u.B = Bkv + (size_t)pn * b_tstep; }
        u.pm = pm; u.pn = pn; return true;
    }
};
struct SchedMoe {
    const char* A; size_t a_tstep; const char* W; size_t w_estep, b_tstep; int nM, nN, G, c; const LAS int* tstart;
    __device__ __forceinline__ bool next(int i, Unit& u) const {
        int pm, pn; if (!unit_coords((unsigned)(i * G + c), nM, nN, pm, pn)) return false;
        int e = 0;
#pragma unroll 1
        for (int k = 16; k >= 1; k >>= 1) if (tstart[e + k] <= pm) e += k;
        u.pm = pm; u.pn = pn; u.e = e; u.A = A + (size_t)pm * a_tstep; u.B = W + (size_t)e * w_estep + (size_t)pn * b_tstep; return true;
    }
};

typedef f32x4 Acc[2][2][4][2];

template <class Epi, class Sched, bool GATHER = false>
__device__ __forceinline__ void gemm_phase(LAS unsigned char* lds, const int K, const int lda, const Sched& S, const Epi& E, const int wid_s, const LAS int* rowoff = nullptr) {
    const int tid = mk_tid(wid_s);
    const int wid = wid_s, lane = tid & 63, wr = wid >> 2, wc = wid & 3, fr = lane & 15, fq = lane >> 4;
    const int nt = K / BK;
    unsigned voffA[2], voffB[2];
#pragma unroll
    for (int i = 0; i < 2; ++i) { int R, C; stage_rc(tid * 16 + i * 8192, R, C); const int Rb = (R & ~31) + perm32(R & 31);
        voffA[i] = (unsigned)(R * lda + C) * 2u; voffB[i] = (unsigned)(Rb * K + C) * 2u; }
    const size_t kstep = (size_t)(BK * 2);
    const size_t hstepA = GATHER ? (size_t)0 : (size_t)HALF * lda * 2, hstepB = (size_t)HALF * K * 2;
    int gR[2], gC[2];
#pragma unroll
    for (int i = 0; i < 2; ++i) stage_rc(tid * 16 + i * 8192, gR[i], gC[i]);
    unsigned gcur[2][2], gnxt[2][2];
#define PG8_GLOAD(dst, pm_) do { _Pragma("unroll") for (int h_ = 0; h_ < 2; ++h_) _Pragma("unroll") for (int i_ = 0; i_ < 2; ++i_) dst[h_][i_] = (unsigned)rowoff[(pm_) * 256 + h_ * 128 + gR[i_]] + (unsigned)gC[i_] * 2u; } while (0)
    const unsigned ldsw = (unsigned)wid * 1024u;
    const int aoff = lds_byte(wr * 64 + fr, fq * 8), boff = lds_byte(wc * 32 + fr, fq * 8);
#define PG8_SA(b, h) (((b) * 2 + (h)) * HTB)
#define PG8_SB(b, h) ((4 + (b) * 2 + (h)) * HTB)
#define PG8_STAGE(bufoff, gbase, voff) do { const char* _gb = (const char*)(gbase); asm volatile("" : "+s"(_gb)); _Pragma("unroll") for (int _i = 0; _i < 2; ++_i) \
        __builtin_amdgcn_global_load_lds((const unsigned*)(_gb + (voff)[_i]), (LAS unsigned*)(lds + (bufoff) + ldsw + _i * 8192), 16, 0, 0); } while (0)
#define PG8_STAGEA(bufoff, gbase, h_, usenext) do { if (GATHER) { unsigned go_[2] = {(usenext) ? gnxt[h_][0] : gcur[h_][0], (usenext) ? gnxt[h_][1] : gcur[h_][1]}; PG8_STAGE(bufoff, gbase, go_); } else PG8_STAGE(bufoff, (gbase) + (h_) * hstepA, voffA); } while (0)
#define PG8_LDA(dst, b, h) do { _Pragma("unroll") for (int m = 0; m < 4; ++m) _Pragma("unroll") for (int k = 0; k < 2; ++k) dst[m][k] = *(const LAS bf16x8*)(lds + PG8_SA(b, h) + aoff + m * 2048 + k * 1024); } while (0)
#define PG8_LDB(dst, b, h) do { _Pragma("unroll") for (int n = 0; n < 2; ++n) _Pragma("unroll") for (int k = 0; k < 2; ++k) dst[n][k] = *(const LAS bf16x8*)(lds + PG8_SB(b, h) + boff + n * 2048 + k * 1024); } while (0)
#define PG8_MMA(ai, bj, At, Bt) do { __builtin_amdgcn_s_setprio(1); _Pragma("unroll") for (int m = 0; m < 4; ++m) _Pragma("unroll") for (int n = 0; n < 2; ++n) _Pragma("unroll") for (int k = 0; k < 2; ++k) \
        acc[ai][bj][m][n] = __builtin_amdgcn_mfma_f32_16x16x32_bf16(Bt[n][k], At[m][k], acc[ai][bj][m][n], 0, 0, 0); __builtin_amdgcn_s_setprio(0); } while (0)
#define PG8_WAIT_V(n) asm volatile("s_waitcnt vmcnt(" #n ")" ::: "memory")
#define PG8_WAIT_L(n) asm volatile("s_waitcnt lgkmcnt(" #n ")" ::: "memory")
#define PG8_BAR __builtin_amdgcn_s_barrier()
#define PG8_SCHED __builtin_amdgcn_sched_barrier(0)
    Unit cur, nxt; int ui = 0;
    if (!S.next(0, cur)) return;
    Acc acc;
#pragma unroll
    for (int a = 0; a < 2; ++a)
#pragma unroll
        for (int b = 0; b < 2; ++b)
#pragma unroll
            for (int m = 0; m < 4; ++m)
#pragma unroll
                for (int n = 0; n < 2; ++n) acc[a][b][m][n] = (f32x4){0.f, 0.f, 0.f, 0.f};
    bf16x8 At[4][2], B0[2][2], B1[2][2];
    const char* cA = cur.A; const char* cB = cur.B;
    if (GATHER) { PG8_GLOAD(gcur, 0); }
    PG8_STAGE(PG8_SB(0, 0), cB, voffB); PG8_STAGEA(PG8_SA(0, 0), cA, 0, false); PG8_STAGE(PG8_SB(0, 1), cB + hstepB, voffB); PG8_STAGEA(PG8_SA(0, 1), cA, 1, false);
    if (wr == 1) PG8_BAR;
    PG8_WAIT_V(4); PG8_BAR;
    PG8_STAGE(PG8_SB(1, 0), cB + kstep, voffB); PG8_STAGEA(PG8_SA(1, 0), cA + kstep, 0, false); PG8_STAGE(PG8_SB(1, 1), cB + hstepB + kstep, voffB);
    PG8_WAIT_V(6); PG8_BAR;
    for (;;) {
        const bool has_next = S.next(ui + 1, nxt);
        const char* nA = has_next ? nxt.A : cA; const char* nB = has_next ? nxt.B : cB;
        if (GATHER) { if (has_next) PG8_GLOAD(gnxt, ui + 1); else { _Pragma("unroll") for (int h_ = 0; h_ < 2; ++h_) _Pragma("unroll") for (int i_ = 0; i_ < 2; ++i_) gnxt[h_][i_] = gcur[h_][i_]; } }
#pragma unroll 1
        for (int t = 0; t < nt; t += 2) {
            const bool last = (t == nt - 2);
            const char* a1 = cA + (size_t)(t + 1) * kstep;
            const char* a2 = last ? nA : cA + (size_t)(t + 2) * kstep; const char* b2 = last ? nB : cB + (size_t)(t + 2) * kstep;
            const char* a3 = a2 + kstep; const char* b3 = b2 + kstep;
            PG8_LDB(B0, 0, 0); PG8_SCHED; PG8_LDA(At, 0, 0); PG8_STAGEA(PG8_SA(1, 1), a1, 1, false);
            PG8_WAIT_L(8); PG8_BAR; PG8_WAIT_L(0); PG8_MMA(0, 0, At, B0); PG8_BAR; PG8_SCHED;
            PG8_LDB(B1, 0, 1); PG8_STAGE(PG8_SB(0, 0), b2, voffB);
            PG8_BAR; PG8_WAIT_L(0); PG8_MMA(0, 1, At, B1); PG8_BAR;
            PG8_LDA(At, 0, 1); PG8_STAGEA(PG8_SA(0, 0), a2, 0, last);
            PG8_BAR; PG8_WAIT_L(0); PG8_MMA(1, 0, At, B0); PG8_BAR; PG8_SCHED;
            PG8_STAGE(PG8_SB(0, 1), b2 + hstepB, voffB);
            PG8_WAIT_V(6); PG8_BAR; PG8_MMA(1, 1, At, B1); PG8_BAR;
            PG8_LDB(B0, 1, 0); PG8_SCHED; PG8_LDA(At, 1, 0); PG8_STAGEA(PG8_SA(0, 1), a2, 1, last);
            PG8_WAIT_L(8); PG8_BAR; PG8_WAIT_L(0); PG8_MMA(0, 0, At, B0); PG8_BAR; PG8_SCHED;
            PG8_LDB(B1, 1, 1); PG8_STAGE(PG8_SB(1, 0), b3, voffB);
            PG8_BAR; PG8_WAIT_L(0); PG8_MMA(0, 1, At, B1); PG8_BAR;
            PG8_LDA(At, 1, 1); PG8_STAGEA(PG8_SA(1, 0), a3, 0, last);
            PG8_BAR; PG8_WAIT_L(0); PG8_MMA(1, 0, At, B0); PG8_BAR; PG8_SCHED;
            PG8_STAGE(PG8_SB(1, 1), b3 + hstepB, voffB);
            PG8_WAIT_V(6); PG8_BAR; PG8_MMA(1, 1, At, B1); PG8_BAR;
        }
        E(acc, cur, wr, wc, fr, fq);
        if (!has_next) break;
#pragma unroll
        for (int a = 0; a < 2; ++a)
#pragma unroll
            for (int b = 0; b < 2; ++b)
#pragma unroll
                for (int m = 0; m < 4; ++m)
#pragma unroll
                    for (int n = 0; n < 2; ++n) acc[a][b][m][n] = (f32x4){0.f, 0.f, 0.f, 0.f};
        cur = nxt; cA = nA; cB = nB; ++ui;
        if (GATHER) { _Pragma("unroll") for (int h_ = 0; h_ < 2; ++h_) _Pragma("unroll") for (int i_ = 0; i_ < 2; ++i_) gcur[h_][i_] = gnxt[h_][i_]; }
    }
    PG8_WAIT_V(0);
    if (wr == 0) PG8_BAR;
    PG8_BAR;
#undef PG8_SA
#undef PG8_SB
#undef PG8_STAGE
#undef PG8_LDA
#undef PG8_STAGEA
#undef PG8_GLOAD
#undef PG8_LDB
#undef PG8_MMA
#undef PG8_WAIT_V
#undef PG8_WAIT_L
#undef PG8_BAR
#undef PG8_SCHED
}
}
using pg8::Acc; using pg8::Unit;

#define EPI_ROW(u, ai, m) ((u).pm * 256 + (ai) * 128 + wr * 64 + (m) * 16 + fr)
#define EPI_COL(u, bj) ((u).pn * 256 + (bj) * 128 + wc * 32 + 8 * fq)

#define EPI_PIN(r) asm volatile("" : "+v"(r))
#define EPI_FOR_BJ _Pragma("unroll") for (int bj = 0; bj < 2; ++bj)
#define EPI_FOR_AM _Pragma("unroll") for (int ai = 0; ai < 2; ++ai) _Pragma("unroll") for (int m = 0; m < 4; ++m)
__device__ __forceinline__ u32x4 pack8(const f32x4 a, const f32x4 b) { u32x4 o = {pk_bf16(a[0], a[1]), pk_bf16(a[2], a[3]), pk_bf16(b[0], b[1]), pk_bf16(b[2], b[3])}; return o; }

struct EpiInproj {
    static constexpr bool MID = false;
    bf16_t* P; const float* bias;
    __device__ __forceinline__ void operator()(Acc& acc, const Unit& u, int wr, int wc, int fr, int fq) const {
        f32x4 b0[2], b1[2];
        EPI_FOR_BJ { const int c0 = EPI_COL(u, bj); b0[bj] = (f32x4){0.f, 0.f, 0.f, 0.f}; b1[bj] = b0[bj];
            if (c0 < INW) { b0[bj] = *(const f32x4*)(bias + c0); b1[bj] = *(const f32x4*)(bias + c0 + 4); } }
        EPI_FOR_BJ { const int c0 = EPI_COL(u, bj);
            EPI_FOR_AM { int r = EPI_ROW(u, ai, m); EPI_PIN(r);
                *(u32x4*)(P + (size_t)r * INWP + c0) = pack8(acc[ai][bj][m][0] + b0[bj], acc[ai][bj][m][1] + b1[bj]);
                __builtin_amdgcn_sched_barrier(0); } }
    }
};

struct EpiNone {
    static constexpr bool MID = false;
    float* dummy;
    __device__ __forceinline__ void operator()(Acc& acc, const Unit& u, int wr, int wc, int fr, int fq) const {
        float t = 0.f;
        EPI_FOR_BJ EPI_FOR_AM t += acc[ai][bj][m][0][0] + acc[ai][bj][m][1][3];
        if (t == 12345.678f) dummy[0] = t;
    }
};

struct EpiQ {
    static constexpr bool MID = false;
    bf16_t* Q; const float* rs; const float2* cs;
    __device__ __forceinline__ void operator()(Acc& acc, const Unit& u, int wr, int wc, int fr, int fq) const {
        const bool is_ctx = (u.pm % 33) == 0;
        float sc[2][4];
        EPI_FOR_AM { const int r = EPI_ROW(u, ai, m); sc[ai][m] = rs[r] * QSCALE; }
        EPI_FOR_BJ {
            const int grp = (u.pn * 256 + bj * 128 + wc * 32) >> 5;
            const bool rope = ((grp % 3) == 2) && !is_ctx;
            EPI_FOR_AM { int r = EPI_ROW(u, ai, m); EPI_PIN(r);
                acc[ai][bj][m][0] *= sc[ai][m]; acc[ai][bj][m][1] *= sc[ai][m];
                if (rope) {
                    const int t = (r % RPB) - CTXL;
                    const float2* c2 = cs + (size_t)t * 16 + (fq >> 1) * 8;
#pragma unroll
                    for (int e = 0; e < 8; ++e) {
                        const float v = acc[ai][bj][m][e >> 2][e & 3];
                        const float pv = swz<16>(v);
                        const float2 csv = c2[e];
                        acc[ai][bj][m][e >> 2][e & 3] = v * csv.x + ((fq & 1) ? pv : -pv) * csv.y;
                    }
                }
                __builtin_amdgcn_sched_barrier(0); } }
        EPI_FOR_BJ { const int c0 = EPI_COL(u, bj);
            EPI_FOR_AM { int r = EPI_ROW(u, ai, m); EPI_PIN(r);
                *(u32x4*)(Q + (size_t)r * 768 + c0) = pack8(acc[ai][bj][m][0], acc[ai][bj][m][1]);
                __builtin_amdgcn_sched_barrier(0); } }
    }
};

struct EpiKV {
    static constexpr bool MID = false;
    bf16_t* KN; bf16_t* VT; const float* rs;
    __device__ __forceinline__ void operator()(Acc& acc, const Unit& u, int wr, int wc, int fr, int fq) const {
        float sc[2][4];
        EPI_FOR_AM { const int r = EPI_ROW(u, ai, m); sc[ai][m] = rs[r]; }
        EPI_FOR_BJ { const int c0 = EPI_COL(u, bj);
            EPI_FOR_AM { int r = EPI_ROW(u, ai, m); EPI_PIN(r);
                const f32x4 v0 = acc[ai][bj][m][0] * sc[ai][m], v1 = acc[ai][bj][m][1] * sc[ai][m];
                if (u.pn < 2) *(u32x4*)(KN + (size_t)r * 512 + c0) = pack8(v0, v1);
                else {
                    const int da = c0 - 512, hh = da >> 6, d = da & 63, b = r / RPB, j = r % RPB;
                    bf16_t* base = VT + ((size_t)((b * NH + hh) * 64 + d)) * RPB + j;
                    const u32x4 pk = pack8(v0, v1);
#pragma unroll
                    for (int e = 0; e < 4; ++e) { base[(size_t)(2 * e) * RPB] = (bf16_t)(pk[e] & 0xffffu); base[(size_t)(2 * e + 1) * RPB] = (bf16_t)(pk[e] >> 16); }
                }
                __builtin_amdgcn_sched_barrier(0); } }
    }
};

struct EpiQKV {
    static constexpr bool MID = false;
    EpiQ q; EpiKV kv;
    __device__ __forceinline__ void operator()(Acc& acc, const Unit& u, int wr, int wc, int fr, int fq) const {
        if (u.e == 0) q(acc, u, wr, wc, fr, fq); else kv(acc, u, wr, wc, fr, fq);
    }
};

struct EpiMergeA {
    static constexpr bool MID = false;
    bf16_t* MG; const bf16_t* P;
    __device__ __forceinline__ void operator()(Acc& acc, const Unit& u, int wr, int wc, int fr, int fq) const {
        EPI_FOR_BJ { const int c0 = EPI_COL(u, bj);
            EPI_FOR_AM { int r = EPI_ROW(u, ai, m); EPI_PIN(r);
                const u32x4 ga = *(const u32x4*)(P + (size_t)r * INWP + OFF_GA + c0);
#pragma unroll
                for (int e = 0; e < 8; ++e) acc[ai][bj][m][e >> 2][e & 3] *= sigmoidf_((e & 1) ? bf_hi(ga[e >> 1]) : bf_lo(ga[e >> 1]));
                __builtin_amdgcn_sched_barrier(0); } }
        EPI_FOR_BJ { const int c0 = EPI_COL(u, bj);
            EPI_FOR_AM { int r = EPI_ROW(u, ai, m); EPI_PIN(r);
                *(u32x4*)(MG + (size_t)r * 1024 + c0) = pack8(acc[ai][bj][m][0], acc[ai][bj][m][1]);
                __builtin_amdgcn_sched_barrier(0); } }
    }
};
struct EpiMergeB {
    static constexpr bool MID = false;
    bf16_t* MG; const bf16_t* P;
    __device__ __forceinline__ void operator()(Acc& acc, const Unit& u, int wr, int wc, int fr, int fq) const {
        EPI_FOR_BJ { const int c0 = EPI_COL(u, bj);
            EPI_FOR_AM { int r = EPI_ROW(u, ai, m); EPI_PIN(r);
                const u32x4 gb = *(const u32x4*)(P + (size_t)r * INWP + OFF_GB + c0);
                const u32x4 mo = *(const u32x4*)(MG + (size_t)r * 1024 + c0);
#pragma unroll
                for (int e = 0; e < 8; ++e) {
                    const float g = sigmoidf_((e & 1) ? bf_hi(gb[e >> 1]) : bf_lo(gb[e >> 1])), o = (e & 1) ? bf_hi(mo[e >> 1]) : bf_lo(mo[e >> 1]);
                    acc[ai][bj][m][e >> 2][e & 3] = o + acc[ai][bj][m][e >> 2][e & 3] * g;
                }
                __builtin_amdgcn_sched_barrier(0); } }
        EPI_FOR_BJ { const int c0 = EPI_COL(u, bj);
            EPI_FOR_AM { int r = EPI_ROW(u, ai, m); EPI_PIN(r);
                *(u32x4*)(MG + (size_t)r * 1024 + c0) = pack8(acc[ai][bj][m][0], acc[ai][bj][m][1]);
                __builtin_amdgcn_sched_barrier(0); } }
    }
};

struct EpiOut {
    static constexpr bool MID = false;
    float* RES; const float* x_in; const float* ctx_in; const float* mod; int layer;
    __device__ __forceinline__ void operator()(Acc& acc, const Unit& u, int wr, int wc, int fr, int fq) const {
        const int b = u.pm / 33; const bool is_ctx = (u.pm % 33) == 0;
        const float* g1 = mod + (size_t)(is_ctx ? 4 : b) * 6144 + 2048;
        f32x4 g0[2], g4[2];
        EPI_FOR_BJ { const int c0 = EPI_COL(u, bj); g0[bj] = *(const f32x4*)(g1 + c0); g4[bj] = *(const f32x4*)(g1 + c0 + 4); }
        EPI_FOR_BJ { const int c0 = EPI_COL(u, bj);
            EPI_FOR_AM { int r = EPI_ROW(u, ai, m); EPI_PIN(r);
                const float* xr;
                if (layer == 0) { const int j = r % RPB; xr = is_ctx ? ctx_in + ((size_t)(b * CTXL + j)) * 1024 : x_in + ((size_t)(b * SEQ + j - CTXL)) * 1024; }
                else xr = RES + (size_t)r * 1024;
                const f32x4 x0 = *(const f32x4*)(xr + c0), x4 = *(const f32x4*)(xr + c0 + 4);
                acc[ai][bj][m][0] = x0 * DN_ALPHA + g0[bj] * acc[ai][bj][m][0];
                acc[ai][bj][m][1] = x4 * DN_ALPHA + g4[bj] * acc[ai][bj][m][1];
                __builtin_amdgcn_sched_barrier(0); }
            EPI_FOR_AM { int r = EPI_ROW(u, ai, m); EPI_PIN(r);
                *(f32x4*)(RES + (size_t)r * 1024 + c0) = acc[ai][bj][m][0];
                *(f32x4*)(RES + (size_t)r * 1024 + c0 + 4) = acc[ai][bj][m][1];
                __builtin_amdgcn_sched_barrier(0); } }
    }
};

struct EpiGU {
    static constexpr bool MID = false;
    bf16_t* ACT; const float* bgu;
    __device__ __forceinline__ void operator()(Acc& acc, const Unit& u, int wr, int wc, int fr, int fq) const {
        const int cj = u.pn * 128 + wc * 32 + 8 * fq;
        const float* bb = bgu + (size_t)u.e * 2048;
        const f32x4 bg0 = *(const f32x4*)(bb + cj), bg1 = *(const f32x4*)(bb + cj + 4), bu0 = *(const f32x4*)(bb + 1024 + cj), bu1 = *(const f32x4*)(bb + 1024 + cj + 4);
        EPI_FOR_AM { int r = EPI_ROW(u, ai, m); EPI_PIN(r);
            float v[8];
#pragma unroll
            for (int e = 0; e < 8; ++e) {
                const float gb = (e < 4) ? bg0[e & 3] : bg1[e & 3], ub = (e < 4) ? bu0[e & 3] : bu1[e & 3];
                const float gate = fminf(acc[ai][0][m][e >> 2][e & 3] + gb, SW_LIMIT);
                const float up = fminf(fmaxf(acc[ai][1][m][e >> 2][e & 3] + ub, -SW_LIMIT), SW_LIMIT);
                v[e] = (up + 1.0f) * gate * sigmoidf_(SW_ALPHA * gate);
            }
            u32x4 o = {pk_bf16(v[0], v[1]), pk_bf16(v[2], v[3]), pk_bf16(v[4], v[5]), pk_bf16(v[6], v[7])};
            *(u32x4*)(ACT + (size_t)r * 1024 + cj) = o;
            __builtin_amdgcn_sched_barrier(0); }
    }
};

struct EpiDown {
    static constexpr bool MID = false;
    bf16_t* YS; const float* bdn; const float* gws;
    __device__ __forceinline__ void operator()(Acc& acc, const Unit& u, int wr, int wc, int fr, int fq) const {
        const float* bb = bdn + (size_t)u.e * 1024;
        float g[2][4]; f32x4 b0[2], b1[2];
        EPI_FOR_AM { const int r = EPI_ROW(u, ai, m); g[ai][m] = gws[r]; }
        EPI_FOR_BJ { const int c0 = EPI_COL(u, bj); b0[bj] = *(const f32x4*)(bb + c0); b1[bj] = *(const f32x4*)(bb + c0 + 4); }
        EPI_FOR_BJ { const int c0 = EPI_COL(u, bj);
            EPI_FOR_AM { int r = EPI_ROW(u, ai, m); EPI_PIN(r);
                *(u32x4*)(YS + (size_t)r * 1024 + c0) = pack8((acc[ai][bj][m][0] + b0[bj]) * g[ai][m], (acc[ai][bj][m][1] + b1[bj]) * g[ai][m]);
                __builtin_amdgcn_sched_barrier(0); } }
    }
};

struct ConvJob { const float* src; int ldsrc, k0, n0, Kvalid, Nvalid; const float* kscale; bf16_t* dst; int lddst; };

__device__ __forceinline__ void conv_tile4(const ConvJob (&J)[4], float* T  , const int tid) {
    f32x4 v[8];
    const int n4 = (tid & 63) * 4, jt = n4 >> 6, nn0 = n4 & 63;
    const float* const src0 = J[0].src; const int ld0 = J[0].ldsrc, kb0 = J[0].k0 + (tid >> 6), nb0 = J[0].n0 + n4, kv0 = J[0].Kvalid;
    const bool nok = nb0 < J[0].Nvalid;
#pragma unroll
    for (int it = 0; it < 8; ++it) {
        f32x4 t = {0.f, 0.f, 0.f, 0.f};
        if (nok && kb0 + 8 * it < kv0) t = __builtin_nontemporal_load((const f32x4*)(src0 + (size_t)(kb0 + 8 * it) * ld0 + nb0));
        v[it] = t;
    }
    if (J[0].kscale) {
        const float* const ks = J[0].kscale;
#pragma unroll
        for (int it = 0; it < 8; ++it) { float sc = 1.0f; if (kb0 + 8 * it < kv0) sc = ks[kb0 + 8 * it]; v[it] *= sc; }
    }
    float* const tp0 = T + jt * 4160 + (tid >> 6) * 65 + nn0;
#pragma unroll
    for (int it = 0; it < 8; ++it) { float* tp = tp0 + it * 8 * 65; tp[0] = v[it][0]; tp[1] = v[it][1]; tp[2] = v[it][2]; tp[3] = v[it][3]; }
    __syncthreads();
#pragma unroll
    for (int j = 0; j < 4; ++j) {
        const int nn = tid >> 3, k8 = (tid & 7) * 8;
        const float* tp = T + j * 4160 + k8 * 65 + nn;
        u32x4 o = {pk_bf16(tp[0], tp[65]), pk_bf16(tp[130], tp[195]), pk_bf16(tp[260], tp[325]), pk_bf16(tp[390], tp[455])};
        *(u32x4*)(J[j].dst + (size_t)nn * J[j].lddst + k8) = o;
    }
    __syncthreads();
}

constexpr int CONV_PER_LAYER = 1024 + 48 + 64 + 256 + 256 + 16384 + 8192;

__device__ __forceinline__ void conv_decode(const Args& a, int job, ConvJob& J) {
    const int l = job / CONV_PER_LAYER; int r = job % CONV_PER_LAYER;
    unsigned char* ws = a.ws;
    J.kscale = nullptr; J.Kvalid = 1 << 30; J.Nvalid = 1 << 30;
    if (r < 1024) {
        const int kt = r >> 6, ntl = r & 63;
        J.src = a.in[6] + (size_t)l * 1024 * INW; J.ldsrc = INW; J.k0 = kt * 64; J.n0 = ntl * 64; J.Nvalid = INW;
        J.dst = (bf16_t*)(ws + WS_WTIN) + (size_t)l * INWP * 1024 + (size_t)(ntl * 64) * 1024 + kt * 64; J.lddst = 1024; return;
    }
    r -= 1024;
    if (r < 48) {
        const int kt = r / 12, ntl = r % 12;
        J.src = a.in[10] + (size_t)l * 256 * 768; J.ldsrc = 768; J.k0 = kt * 64; J.n0 = ntl * 64; J.kscale = a.in[8] + l * 256;
        J.dst = (bf16_t*)(ws + WS_WTUQ) + (size_t)l * 768 * 256 + (size_t)(ntl * 64) * 256 + kt * 64; J.lddst = 256; return;
    }
    r -= 48;
    if (r < 64) {
        const int kt = r >> 4, ntl = r & 15;
        J.src = (ntl < 8 ? a.in[11] : a.in[12]) + (size_t)l * 128 * 512; J.ldsrc = 512; J.k0 = kt * 64; J.n0 = (ntl & 7) * 64; J.Kvalid = 128; J.kscale = a.in[9] + l * 128;
        J.dst = (bf16_t*)(ws + WS_WTUKV) + (size_t)l * 1024 * 256 + (size_t)(ntl * 64) * 256 + kt * 64; J.lddst = 256; return;
    }
    r -= 64;
    if (r < 256) {
        const int kt = r >> 4, ntl = r & 15;
        J.src = (kt < 8 ? a.in[13] : a.in[16]) + (size_t)l * 512 * 1024; J.ldsrc = 1024; J.k0 = (kt & 7) * 64; J.n0 = ntl * 64;
        J.dst = (bf16_t*)(ws + WS_WTOAB) + (size_t)l * 1024 * 1024 + (size_t)(kt >> 3) * 1024 * 512 + (size_t)(ntl * 64) * 512 + (kt & 7) * 64; J.lddst = 512; return;
    }
    r -= 256;
    if (r < 256) {
        const int kt = r >> 4, ntl = r & 15;
        J.src = a.in[17] + (size_t)l * 1024 * 1024; J.ldsrc = 1024; J.k0 = kt * 64; J.n0 = ntl * 64;
        J.dst = (bf16_t*)(ws + WS_WTO) + (size_t)l * 1024 * 1024 + (size_t)(ntl * 64) * 1024 + kt * 64; J.lddst = 1024; return;
    }
    r -= 256;
    if (r < 16384) {
        const int e = r >> 9, rr = r & 511, kt = rr >> 5, ntl = rr & 31, n0 = ntl * 64;
        J.src = a.in[24] + ((size_t)(l * NEXP + e)) * 1024 * 2048; J.ldsrc = 2048; J.k0 = kt * 64; J.n0 = n0;
        const int jj = n0 & 1023, row0 = (jj >> 7) * 256 + (n0 >= 1024 ? 128 : 0) + (jj & 127);
        J.dst = (bf16_t*)(ws + WS_WTGU) + ((size_t)(l * NEXP + e)) * 2048 * 1024 + (size_t)row0 * 1024 + kt * 64; J.lddst = 1024; return;
    }
    r -= 16384;
    {
        const int e = r >> 8, rr = r & 255, kt = rr >> 4, ntl = rr & 15;
        J.src = a.in[26] + ((size_t)(l * NEXP + e)) * 1024 * 1024; J.ldsrc = 1024; J.k0 = kt * 64; J.n0 = ntl * 64;
        J.dst = (bf16_t*)(ws + WS_WTDN) + ((size_t)(l * NEXP + e)) * 1024 * 1024 + (size_t)(ntl * 64) * 1024 + kt * 64; J.lddst = 1024;
    }
}

__device__ __forceinline__ void p0_phase(const Args& a, unsigned char* ldsg, const int wid_s) {
    const int tid = mk_tid(wid_s), G = gridDim.x, bid = blockIdx.x;
    float* LF = (float*)ldsg;
    if (bid == 0) { ((int*)(a.ws + WS_CTL))[tid] = 0; ((int*)(a.ws + WS_CTL))[tid + 512] = 0; }
    for (int idx = bid * NTHREADS + tid; idx < SEQ * 16; idx += G * NTHREADS) {
        const int t = idx >> 4, i = idx & 15;
        const float pos = (float)((i < 8) ? (t >> 6) : (t & 63));
        const float fr_ = powf(10000.0f, -(float)(2 * (i & 7)) / 16.0f);
        const float ang = pos * fr_;
        const double turns = (double)ang * 0.15915494309189535;
        const float frac = (float)(turns - rint(turns));
        ((float2*)(a.ws + WS_ROPE))[idx] = make_float2(__builtin_amdgcn_cosf(frac), __builtin_amdgcn_sinf(frac));
    }
    for (int job = bid; job < DEPTH * 96; job += G) {
        const int l = job / 96, g = job % 96;
        for (int i = tid; i < 5 * 1024; i += NTHREADS) {
            const int m = i >> 10, k = i & 1023;
            const float c = (m < 4) ? a.in[1][m * 1024 + k] : a.in[3][k];
            LF[i] = c / (1.0f + __expf(-c));
        }
        __syncthreads();
        const int col = g * 64 + (tid & 63), kq = tid >> 6;
        const float* w = a.in[4] + (size_t)l * 1024 * 6144 + col;
        float s0 = 0.f, s1 = 0.f, s2 = 0.f, s3 = 0.f, s4 = 0.f;
#pragma unroll 32
        for (int k = kq * 128; k < kq * 128 + 128; ++k) {
            const float wv = w[(size_t)k * 6144];
            s0 += LF[k] * wv; s1 += LF[1024 + k] * wv; s2 += LF[2048 + k] * wv; s3 += LF[3072 + k] * wv; s4 += LF[4096 + k] * wv;
        }
        float* red = LF + 5120;
        red[(kq * 5 + 0) * 64 + (tid & 63)] = s0; red[(kq * 5 + 1) * 64 + (tid & 63)] = s1; red[(kq * 5 + 2) * 64 + (tid & 63)] = s2;
        red[(kq * 5 + 3) * 64 + (tid & 63)] = s3; red[(kq * 5 + 4) * 64 + (tid & 63)] = s4;
        __syncthreads();
        if (tid < 320) {
            const int m = tid >> 6, cc = tid & 63; float s = 0.f;
#pragma unroll
            for (int q = 0; q < 8; ++q) s += red[(q * 5 + m) * 64 + cc];
            ((float*)(a.ws + WS_MOD))[((size_t)(l * 5 + m)) * 6144 + g * 64 + cc] = s + a.in[5][l * 6144 + g * 64 + cc];
        }
        __syncthreads();
    }
    for (int job = bid * 4; job < DEPTH * CONV_PER_LAYER; job += G * 4) { ConvJob J[4]; conv_decode(a, job, J[0]); conv_decode(a, job + 1, J[1]); conv_decode(a, job + 2, J[2]); conv_decode(a, job + 3, J[3]); conv_tile4(J, LF, tid); }
}

__device__ __forceinline__ void p1_phase(const Args& a, const int wid_s) {
    const int tid_ = mk_tid(wid_s);
    const int lane = tid_ & 63, gw = blockIdx.x * 8 + (tid_ >> 6), nw = gridDim.x * 8;
    const float* mod = (const float*)(a.ws + WS_MOD);
    bf16_t* HB = (bf16_t*)(a.ws + WS_HB);
    f32x4 xn[4];
    const float* const x_in = a.in[0]; const float* const c_in = a.in[2];
#define P1_LOAD(Rq) do { const int Rc_ = min((Rq), MR - 1); const int b_ = Rc_ / RPB, j_ = Rc_ % RPB; \
        const float* src_ = (j_ < CTXL) ? c_in + ((size_t)(b_ * CTXL + j_)) * 1024 : x_in + ((size_t)(b_ * SEQ + j_ - CTXL)) * 1024; \
        _Pragma("unroll") for (int i = 0; i < 4; ++i) xn[i] = *(const f32x4*)(src_ + (lane + 64 * i) * 4); } while (0)
    P1_LOAD(gw);
    for (int R = gw; R < MR; R += nw) {
        const int b = R / RPB, j = R % RPB;
        const float* md = mod + (size_t)((j < CTXL) ? 4 : b) * 6144;
        f32x4 xc[4];
#pragma unroll
        for (int i = 0; i < 4; ++i) xc[i] = xn[i];
        P1_LOAD(R + nw);
#pragma unroll
        for (int i = 0; i < 4; ++i) {
            const int k = (lane + 64 * i) * 4;
            const f32x4 sh = *(const f32x4*)(md + k), sc = *(const f32x4*)(md + 1024 + k);
            const f32x4 h = xc[i] * (sc + 1.0f) + sh;
            u32x2 o = {pk_bf16(h[0], h[1]), pk_bf16(h[2], h[3])};
            *(u32x2*)(HB + (size_t)R * 1024 + k) = o;
        }
    }
#undef P1_LOAD
}

__device__ __forceinline__ void rowa_phase(const Args& a, int l, const int wid_s) {
    const int tid_ = mk_tid(wid_s);
    const int lane = tid_ & 63, gw = blockIdx.x * 8 + (tid_ >> 6), nw = gridDim.x * 8;
    const bf16_t* P = (const bf16_t*)(a.ws + WS_P);
    float* rsq = (float*)(a.ws + WS_RSQ); float* rskv = (float*)(a.ws + WS_RSKV);
    bf16_t* KR = (bf16_t*)(a.ws + WS_KR); bf16_t* AC = (bf16_t*)(a.ws + WS_AC);
    const float2* cs = (const float2*)(a.ws + WS_ROPE);
    const float* cw = a.in[14] + (size_t)l * 3 * 512; const float* cb = a.in[15] + (size_t)l * 512;
    const int c8 = lane * 8;
    float w0[8], w1[8], w2[8], bs[8];
#pragma unroll
    for (int e = 0; e < 8; ++e) { w0[e] = cw[c8 + e]; w1[e] = cw[512 + c8 + e]; w2[e] = cw[1024 + c8 + e]; bs[e] = cb[c8 + e]; }
    u32x2 nqa; unsigned nka; bf16_t nkr; u32x4 nuc, nbc, ncc, nup, ncp, nun, ncn;
#define RA_LOAD(Rq) do { const int Rc_ = min((Rq), MR - 1); const bf16_t* pr_ = P + (size_t)Rc_ * INWP; const int j_ = Rc_ % RPB; \
        const bool hp_ = (j_ != 0) && (j_ != CTXL), hn_ = (j_ != CTXL - 1) && (j_ != RPB - 1); const u32x4 z_ = {0u, 0u, 0u, 0u}; \
        nqa = *(const u32x2*)(pr_ + lane * 4); nka = *(const unsigned*)(pr_ + OFF_KV + lane * 2); nkr = pr_[OFF_KR + (lane & 31)]; \
        nuc = *(const u32x4*)(pr_ + OFF_CX + c8); nbc = *(const u32x4*)(pr_ + OFF_CB + c8); ncc = *(const u32x4*)(pr_ + OFF_CC + c8); \
        nup = hp_ ? *(const u32x4*)(pr_ - INWP + OFF_CX + c8) : z_; ncp = hp_ ? *(const u32x4*)(pr_ - INWP + OFF_CC + c8) : z_; \
        nun = hn_ ? *(const u32x4*)(pr_ + INWP + OFF_CX + c8) : z_; ncn = hn_ ? *(const u32x4*)(pr_ + INWP + OFF_CC + c8) : z_; } while (0)
    RA_LOAD(gw);
    for (int R = gw; R < MR; R += nw) {
        const int j = R % RPB;
        const u32x2 qa = nqa; const unsigned ka = nka; const bf16_t krv = nkr;
        const u32x4 uc = nuc, bc = nbc, cc = ncc, up = nup, cp = ncp, un = nun, cn = ncn;
        RA_LOAD(R + nw);
        float sq = bf_lo(qa[0]) * bf_lo(qa[0]) + bf_hi(qa[0]) * bf_hi(qa[0]) + bf_lo(qa[1]) * bf_lo(qa[1]) + bf_hi(qa[1]) * bf_hi(qa[1]);
        float sk = bf_lo(ka) * bf_lo(ka) + bf_hi(ka) * bf_hi(ka);
        sq = wave_sum(sq, lane); sk = wave_sum(sk, lane);
        if (lane == 0) { rsq[R] = rsqrtf(sq * (1.0f / 256.0f) + NORM_EPS); rskv[R] = rsqrtf(sk * (1.0f / 128.0f) + NORM_EPS); }
        {
            const float v = bf2f(krv);
            const float pv = swz<8>(v);
            float o = v;
            if (j >= CTXL) { const int i = lane & 31; const float2 c2 = cs[(size_t)(j - CTXL) * 16 + (i >> 4) * 8 + (i & 7)]; o = v * c2.x + (((i >> 3) & 1) ? pv : -pv) * c2.y; }
            const float o2 = swz<1>(o);
            if (lane < 32 && !(lane & 1)) *(unsigned*)(KR + (size_t)R * 32 + lane) = pk_bf16(o, o2);
        }
        float y[8];
#pragma unroll
        for (int e = 0; e < 8; ++e) {
            const int q = e >> 1;
            const float zc = (e & 1) ? bf_hi(uc[q]) * bf_hi(cc[q]) : bf_lo(uc[q]) * bf_lo(cc[q]);
            const float zp = (e & 1) ? bf_hi(up[q]) * bf_hi(cp[q]) : bf_lo(up[q]) * bf_lo(cp[q]);
            const float zn = (e & 1) ? bf_hi(un[q]) * bf_hi(cn[q]) : bf_lo(un[q]) * bf_lo(cn[q]);
            const float bg = (e & 1) ? bf_hi(bc[q]) : bf_lo(bc[q]);
            y[e] = bg * (w0[e] * zp + w1[e] * zc + w2[e] * zn + bs[e]);
        }
        u32x4 o = {pk_bf16(y[0], y[1]), pk_bf16(y[2], y[3]), pk_bf16(y[4], y[5]), pk_bf16(y[6], y[7])};
        *(u32x4*)(AC + (size_t)R * 1024 + 512 + c8) = o;
    }
#undef RA_LOAD
}

__device__ __forceinline__ void router_tail(const f32x16 plo, const f32x16 phi, const int lane, const float* br_, const bool live, const int lrow, int* lcnt, int* rec_e, int* rec_p, float* rec_g) {
    const bool u5 = (lane & 32) != 0, u4 = (lane & 16) != 0, u3 = (lane & 8) != 0, u2 = (lane & 4) != 0, u1 = (lane & 2) != 0;
    f32x16 k16 = u5 ? phi : plo; const f32x16 s16 = u5 ? plo : phi;
#pragma unroll
    for (int i = 0; i < 16; ++i) k16[i] += shx32(s16[i], lane);
    f32x8 k8 = u4 ? k16.hi : k16.lo; const f32x8 s8 = u4 ? k16.lo : k16.hi;
#pragma unroll
    for (int i = 0; i < 8; ++i) k8[i] += swz<16>(s8[i]);
    f32x4 k4 = u3 ? k8.hi : k8.lo; const f32x4 s4 = u3 ? k8.lo : k8.hi;
#pragma unroll
    for (int i = 0; i < 4; ++i) k4[i] += swz<8>(s4[i]);
    f32x2 k2 = u2 ? k4.hi : k4.lo; const f32x2 s2 = u2 ? k4.lo : k4.hi;
#pragma unroll
    for (int i = 0; i < 2; ++i) k2[i] += swz<4>(s2[i]);
    float k1 = u1 ? k2.y : k2.x; const float s1 = u1 ? k2.x : k2.y;
    k1 += swz<2>(s1);
    const int myE = lane >> 1;
    const float mylog = k1 + swz<1>(k1) + br_[myE];
    int rank = 0;
#pragma unroll
    for (int e = 0; e < 32; ++e) {
        const float le = __uint_as_float(__builtin_amdgcn_readlane(__float_as_uint(mylog), 2 * e));
        rank += ((le > mylog) || (le == mylog && e < myE)) ? 1 : 0;
    }
    const bool even = !(lane & 1);
    const unsigned long long m0 = __ballot(even && rank == 0), m1 = __ballot(even && rank == 1), m2 = __ballot(even && rank == 2), m3 = __ballot(even && rank == 3);
    const float v0 = __uint_as_float(__builtin_amdgcn_readlane(__float_as_uint(mylog), __builtin_ctzll(m0)));
    const float v1 = __uint_as_float(__builtin_amdgcn_readlane(__float_as_uint(mylog), __builtin_ctzll(m1)));
    const float v2 = __uint_as_float(__builtin_amdgcn_readlane(__float_as_uint(mylog), __builtin_ctzll(m2)));
    const float v3 = __uint_as_float(__builtin_amdgcn_readlane(__float_as_uint(mylog), __builtin_ctzll(m3)));
    const float inv = 1.0f / (1.0f + __expf(v1 - v0) + __expf(v2 - v0) + __expf(v3 - v0));
    if (live && even && rank < 4) {
        const float g = __expf(mylog - v0) * inv;
        const int lp = atomicAdd(&lcnt[myE], 1);
        const int li = lrow * 4 + rank;
        rec_e[li] = myE; rec_p[li] = lp; rec_g[li] = g;
    }
}

__device__ __forceinline__ void ln1_router_phase(const Args& a, int l, unsigned char* ldsg, const int wid_s) {
    const int tid_ = mk_tid(wid_s);
    const int tid = tid_, lane = tid & 63, wid = tid >> 6, G = gridDim.x, bid = blockIdx.x;
    float* WT = (float*)ldsg;
    int* lcnt = (int*)(ldsg + MISC_OFF);
    int* lbase = lcnt + 32;
    int* rec_e = lbase + 32;
    int* rec_p = rec_e + 1024;
    float* rec_g = (float*)(rec_p + 1024);
    const float* wr_ = a.in[22] + (size_t)l * 1024 * 32; const float* br_ = a.in[23] + l * 32;
    {
        f32x4 wv[16];
#pragma unroll
        for (int j = 0; j < 16; ++j) wv[j] = *(const f32x4*)(wr_ + (size_t)(tid + NTHREADS * j) * 4);
#pragma unroll
        for (int j = 0; j < 16; ++j) { const int idx = (tid + NTHREADS * j) * 4, k = idx >> 5, e = idx & 31;
#pragma unroll
            for (int c = 0; c < 4; ++c) WT[(e + c) * 1024 + k] = wv[j][c]; }
    }
    if (tid < 32) lcnt[tid] = 0;
    __syncthreads();
    const int rpb = (MR + G - 1) / G, r0 = bid * rpb, r1 = min(MR, r0 + rpb);
    float* RES = (float*)(a.ws + WS_RES); bf16_t* HB = (bf16_t*)(a.ws + WS_HB);
    const float* mod = (const float*)(a.ws + WS_MOD) + (size_t)l * 5 * 6144;
    const float* lg_ = a.in[18] + l * 1024; const float* lb_ = a.in[19] + l * 1024;
    const bool lastl = (l == DEPTH - 1);
    f32x4 na[4], nb[4];
#define L1_LOAD(Rq) do { const int Ra_ = min((Rq), MR - 1), Rb_ = min((Rq) + 8, MR - 1); _Pragma("unroll") for (int i = 0; i < 4; ++i) { \
        na[i] = *(const f32x4*)(RES + (size_t)Ra_ * 1024 + (lane + 64 * i) * 4); nb[i] = *(const f32x4*)(RES + (size_t)Rb_ * 1024 + (lane + 64 * i) * 4); } } while (0)
    L1_LOAD(r0 + wid);
    for (int Ra = r0 + wid; Ra < r1; Ra += 16) {
        const bool has2 = (Ra + 8 < r1);
        const int Rb = has2 ? Ra + 8 : Ra;
        f32x4 va[4], vb[4];
#pragma unroll
        for (int i = 0; i < 4; ++i) { va[i] = na[i]; vb[i] = has2 ? nb[i] : na[i]; }
        L1_LOAD(Ra + 16);
        const int ja = Ra % RPB, jb = Rb % RPB;
        const bool livea = !(lastl && ja < CTXL), liveb = has2 && !(lastl && jb < CTXL);
        if (!livea && !liveb) continue;
        const float* mda = mod + (size_t)((ja < CTXL) ? 4 : Ra / RPB) * 6144;
        const float* mdb = mod + (size_t)((jb < CTXL) ? 4 : Rb / RPB) * 6144;
        float sa_ = 0.f, sb_ = 0.f;
#pragma unroll
        for (int i = 0; i < 4; ++i) { sa_ += va[i][0] + va[i][1] + va[i][2] + va[i][3]; sb_ += vb[i][0] + vb[i][1] + vb[i][2] + vb[i][3]; }
        const float mua = wave_sum(sa_, lane) * (1.0f / 1024.0f), mub = wave_sum(sb_, lane) * (1.0f / 1024.0f);
        float qa = 0.f, qb = 0.f;
#pragma unroll
        for (int i = 0; i < 4; ++i) { va[i] = va[i] - mua; vb[i] = vb[i] - mub; qa += va[i][0] * va[i][0] + va[i][1] * va[i][1] + va[i][2] * va[i][2] + va[i][3] * va[i][3]; qb += vb[i][0] * vb[i][0] + vb[i][1] * vb[i][1] + vb[i][2] * vb[i][2] + vb[i][3] * vb[i][3]; }
        const float rsa = rsqrtf(wave_sum(qa, lane) * (1.0f / 1024.0f) + NORM_EPS), rsb = rsqrtf(wave_sum(qb, lane) * (1.0f / 1024.0f) + NORM_EPS);
        f32x2 hp[4][4];
#pragma unroll
        for (int i = 0; i < 4; ++i) {
            const int k = (lane + 64 * i) * 4;
            const f32x4 gg = *(const f32x4*)(lg_ + k), bb = *(const f32x4*)(lb_ + k);
            const f32x4 xa = va[i] * rsa * gg + bb, xb = vb[i] * rsb * gg + bb;
            const f32x4 ha = xa * (*(const f32x4*)(mda + 4096 + k) + 1.0f) + *(const f32x4*)(mda + 3072 + k);
            const f32x4 hb = xb * (*(const f32x4*)(mdb + 4096 + k) + 1.0f) + *(const f32x4*)(mdb + 3072 + k);
#pragma unroll
            for (int c = 0; c < 4; ++c) hp[i][c] = (f32x2){ha[c], hb[c]};
            if (livea) { *(f32x4*)(RES + (size_t)Ra * 1024 + k) = xa; u32x2 o = {pk_bf16(ha[0], ha[1]), pk_bf16(ha[2], ha[3])}; *(u32x2*)(HB + (size_t)Ra * 1024 + k) = o; }
            if (liveb) { *(f32x4*)(RES + (size_t)Rb * 1024 + k) = xb; u32x2 o = {pk_bf16(hb[0], hb[1]), pk_bf16(hb[2], hb[3])}; *(u32x2*)(HB + (size_t)Rb * 1024 + k) = o; }
        }
        f32x2 pl2[32];
#pragma unroll
        for (int e = 0; e < 32; ++e) {
            f32x2 acc2 = {0.f, 0.f};
#pragma unroll
            for (int i = 0; i < 4; ++i) {
                const f32x4 w = *(const f32x4*)(WT + e * 1024 + (lane + 64 * i) * 4);
#pragma unroll
                for (int c = 0; c < 4; ++c) acc2 = __builtin_elementwise_fma(hp[i][c], (f32x2){w[c], w[c]}, acc2);
            }
            pl2[e] = acc2;
            if ((e & 3) == 3) __builtin_amdgcn_sched_barrier(0);
        }
        {
            const f32x16 plo = {pl2[0].x, pl2[1].x, pl2[2].x, pl2[3].x, pl2[4].x, pl2[5].x, pl2[6].x, pl2[7].x, pl2[8].x, pl2[9].x, pl2[10].x, pl2[11].x, pl2[12].x, pl2[13].x, pl2[14].x, pl2[15].x};
            const f32x16 phi = {pl2[16].x, pl2[17].x, pl2[18].x, pl2[19].x, pl2[20].x, pl2[21].x, pl2[22].x, pl2[23].x, pl2[24].x, pl2[25].x, pl2[26].x, pl2[27].x, pl2[28].x, pl2[29].x, pl2[30].x, pl2[31].x};
            router_tail(plo, phi, lane, br_, livea, Ra - r0, lcnt, rec_e, rec_p, rec_g);
        }
        {
            const f32x16 plo = {pl2[0].y, pl2[1].y, pl2[2].y, pl2[3].y, pl2[4].y, pl2[5].y, pl2[6].y, pl2[7].y, pl2[8].y, pl2[9].y, pl2[10].y, pl2[11].y, pl2[12].y, pl2[13].y, pl2[14].y, pl2[15].y};
            const f32x16 phi = {pl2[16].y, pl2[17].y, pl2[18].y, pl2[19].y, pl2[20].y, pl2[21].y, pl2[22].y, pl2[23].y, pl2[24].y, pl2[25].y, pl2[26].y, pl2[27].y, pl2[28].y, pl2[29].y, pl2[30].y, pl2[31].y};
            router_tail(plo, phi, lane, br_, liveb, Rb - r0, lcnt, rec_e, rec_p, rec_g);
        }
    }
#undef L1_LOAD
    __syncthreads();
    if (tid < 32) lbase[tid] = atomicAdd((int*)(a.ws + WS_CTL) + l * 32 + tid, lcnt[tid]);
    __syncthreads();
    int* RE = (int*)(a.ws + WS_RE); int* RP = (int*)(a.ws + WS_RPOS); float* RG = (float*)(a.ws + WS_RG);
    for (int i = tid; i < (r1 - r0) * 4; i += NTHREADS) {
        if (lastl && ((r0 + (i >> 2)) % RPB) < CTXL) continue;
        const int e = rec_e[i];
        RE[(size_t)r0 * 4 + i] = e; RP[(size_t)r0 * 4 + i] = lbase[e] + rec_p[i]; RG[(size_t)r0 * 4 + i] = rec_g[i];
    }
    __syncthreads();
}

__device__ __forceinline__ void moe_prefix(const Args& a, int l, unsigned char* ldsg, const int wid_s) {
    int* ts = (int*)(ldsg + MISC_OFF);
    __syncthreads();
    if (wid_s == 0 && lane_id() == 0) {
        const int* cnt = (const int*)(a.ws + WS_CTL) + l * 32; int acc_ = 0;
#pragma unroll 1
        for (int e = 0; e < 32; ++e) { ts[e] = acc_; ts[40 + e] = __hip_atomic_load(cnt + e, __ATOMIC_RELAXED, __HIP_MEMORY_SCOPE_AGENT); acc_ += (__hip_atomic_load(cnt + e, __ATOMIC_RELAXED, __HIP_MEMORY_SCOPE_AGENT) + 255) >> 8; }
        ts[32] = acc_;
    }
    __syncthreads();
}

__device__ __forceinline__ void gather_phase(const Args& a, int l, unsigned char* ldsg, const int wid_s) {
    moe_prefix(a, l, ldsg, wid_s);
    const int* ts = (const int*)(ldsg + MISC_OFF);
    const int tid = mk_tid(wid_s);
    const int* RE = (const int*)(a.ws + WS_RE); const int* RP = (const int*)(a.ws + WS_RPOS); const float* RG = (const float*)(a.ws + WS_RG);
    int* SO = (int*)(a.ws + WS_SLOTOF); float* GWS = (float*)(a.ws + WS_GWS); int* RO = (int*)(a.ws + WS_ROWOFF);
    const int G = gridDim.x;
    for (int i = blockIdx.x * NTHREADS + tid; i < MR * 4; i += G * NTHREADS) {
        const int R = i >> 2;
        if (l == DEPTH - 1 && (R % RPB) < CTXL) continue;
        const int slot = ts[RE[i] & 31] * 256 + RP[i];
        SO[i] = slot; GWS[slot] = RG[i]; RO[slot] = R * 2048;
    }
    for (int e = blockIdx.x; e < NEXP; e += G) {
        const int beg = ts[e] * 256 + ts[40 + e], end = ts[e + 1] * 256;
        for (int sl = beg + tid; sl < end; sl += NTHREADS) { RO[sl] = 0; GWS[sl] = 0.f; }
    }
}

__device__ __forceinline__ void ln2_phase(const Args& a, int l, const int wid_s) {
    const int tid_ = mk_tid(wid_s);
    const int lane = tid_ & 63, gw = blockIdx.x * 8 + (tid_ >> 6), nw = gridDim.x * 8;
    float* RES = (float*)(a.ws + WS_RES); bf16_t* HB = (bf16_t*)(a.ws + WS_HB); const bf16_t* YS = (const bf16_t*)(a.ws + WS_AS);
    const int* SO = (const int*)(a.ws + WS_SLOTOF);
    const float* mod = (const float*)(a.ws + WS_MOD) + (size_t)l * 5 * 6144;
    const float* modn = (const float*)(a.ws + WS_MOD) + (size_t)((l + 1) % DEPTH) * 5 * 6144;
    const float* lg_ = a.in[20] + l * 1024; const float* lb_ = a.in[21] + l * 1024;
    const bool last = (l == DEPTH - 1);
    int sl1[4], sl2[4];
    u32x2 ysn[4][4]; f32x4 rsn[4];
#define LN2_SLOTS(dst, Rq) do { const int Rc_ = min((Rq), MR - 1); _Pragma("unroll") for (int k = 0; k < 4; ++k) dst[k] = SO[Rc_ * 4 + k]; } while (0)
#define LN2_ROWS(Rq, slq) do { const int Rc_ = min((Rq), MR - 1); const bool skip_ = last && (Rc_ % RPB) < CTXL; _Pragma("unroll") for (int i = 0; i < 4; ++i) { const int k0_ = (lane + 64 * i) * 4; \
        rsn[i] = *(const f32x4*)(RES + (size_t)Rc_ * 1024 + k0_); _Pragma("unroll") for (int k = 0; k < 4; ++k) ysn[i][k] = *(const u32x2*)(YS + (size_t)(skip_ ? 0 : slq[k]) * 1024 + k0_); } } while (0)
    LN2_SLOTS(sl1, gw); LN2_SLOTS(sl2, gw + nw);
    LN2_ROWS(gw, sl1);
#pragma unroll
    for (int k = 0; k < 4; ++k) sl1[k] = sl2[k];
    for (int R = gw; R < MR; R += nw) {
        u32x2 ys[4][4]; f32x4 v[4];
#pragma unroll
        for (int i = 0; i < 4; ++i) { v[i] = rsn[i];
#pragma unroll
            for (int k = 0; k < 4; ++k) ys[i][k] = ysn[i][k]; }
        LN2_SLOTS(sl2, R + 2 * nw);
        LN2_ROWS(R + nw, sl1);
#pragma unroll
        for (int k = 0; k < 4; ++k) sl1[k] = sl2[k];
        const int b = R / RPB, j = R % RPB; const int mi = (j < CTXL) ? 4 : b;
        if (last && j < CTXL) continue;
        const float* md = mod + (size_t)mi * 6144;
        float* rr = RES + (size_t)R * 1024;
        float s = 0.f;
#pragma unroll
        for (int i = 0; i < 4; ++i) {
            const int k0 = (lane + 64 * i) * 4;
            f32x4 f = {0.f, 0.f, 0.f, 0.f};
#pragma unroll
            for (int k = 0; k < 4; ++k) { const u32x2 y = ys[i][k]; f[0] += bf_lo(y[0]); f[1] += bf_hi(y[0]); f[2] += bf_lo(y[1]); f[3] += bf_hi(y[1]); }
            v[i] = v[i] * DN_ALPHA + *(const f32x4*)(md + 5120 + k0) * f;
            s += v[i][0] + v[i][1] + v[i][2] + v[i][3];
        }
        const float mu = wave_sum(s, lane) * (1.0f / 1024.0f);
        float q = 0.f;
#pragma unroll
        for (int i = 0; i < 4; ++i) { v[i] = v[i] - mu; q += v[i][0] * v[i][0] + v[i][1] * v[i][1] + v[i][2] * v[i][2] + v[i][3] * v[i][3]; }
        const float rstd = rsqrtf(wave_sum(q, lane) * (1.0f / 1024.0f) + NORM_EPS);
#pragma unroll
        for (int i = 0; i < 4; ++i) {
            const int k0 = (lane + 64 * i) * 4;
            const f32x4 x2 = v[i] * rstd * *(const f32x4*)(lg_ + k0) + *(const f32x4*)(lb_ + k0);
            if (last) { *(f32x4*)(a.out + ((size_t)(b * SEQ + j - CTXL)) * 1024 + k0) = x2; }
            else {
                *(f32x4*)(rr + k0) = x2;
                const float* mn = modn + (size_t)mi * 6144;
                const f32x4 h = x2 * (*(const f32x4*)(mn + 1024 + k0) + 1.0f) + *(const f32x4*)(mn + k0);
                u32x2 o = {pk_bf16(h[0], h[1]), pk_bf16(h[2], h[3])};
                *(u32x2*)(HB + (size_t)R * 1024 + k0) = o;
            }
        }
    }
#undef LN2_SLOTS
#undef LN2_ROWS
}

constexpr int KROW = 208, VROW = 136, KBUF = 64 * KROW, VBUF = 64 * VROW, KVBUF = KBUF + VBUF;

template <int MODE> __device__ __forceinline__ f32x16 att_mma(const bf16x8 a_, const bf16x8 b_, f32x16 c_) {
    if (MODE == 2) { c_[0] += __builtin_bit_cast(f32x4, a_)[0] + __builtin_bit_cast(f32x4, b_)[1]; return c_; }
    return __builtin_amdgcn_mfma_f32_32x32x16_bf16(a_, b_, c_, 0, 0, 0);
}
#define ATT_MMA(a_, b_, c_, x_, y_, z_) att_mma<MODE>(a_, b_, c_)
template <int MODE>
__device__ __forceinline__ void attn_qk(const LAS unsigned char* kb_, const bf16x8 (&qf)[6], f32x16 (&st)[2], const int ql, const int hf) {
#define ATT_KF(kb, s) (*(const LAS bf16x8*)(kb_ + ((kb) * 32 + ql) * KROW + (s) * 32 + hf * 16))
    bf16x8 ka[4], kc[4], ke[4];
#pragma unroll
    for (int s = 0; s < 2; ++s) { ka[2 * s] = ATT_KF(0, s); ka[2 * s + 1] = ATT_KF(1, s); }
#pragma unroll
    for (int s = 2; s < 4; ++s) { kc[2 * (s - 2)] = ATT_KF(0, s); kc[2 * (s - 2) + 1] = ATT_KF(1, s); }
    __builtin_amdgcn_sched_barrier(0);
#pragma unroll
    for (int i = 0; i < 16; ++i) { st[0][i] = 0.f; st[1][i] = 0.f; }
#pragma unroll
    for (int s = 0; s < 2; ++s) { st[0] = ATT_MMA(ka[2 * s], qf[s], st[0], 0, 0, 0); st[1] = ATT_MMA(ka[2 * s + 1], qf[s], st[1], 0, 0, 0); }
    __builtin_amdgcn_sched_barrier(0);
#pragma unroll
    for (int s = 4; s < 6; ++s) { ke[2 * (s - 4)] = ATT_KF(0, s); ke[2 * (s - 4) + 1] = ATT_KF(1, s); }
    __builtin_amdgcn_sched_barrier(0);
#pragma unroll
    for (int s = 2; s < 4; ++s) { st[0] = ATT_MMA(kc[2 * (s - 2)], qf[s], st[0], 0, 0, 0); st[1] = ATT_MMA(kc[2 * (s - 2) + 1], qf[s], st[1], 0, 0, 0); }
#pragma unroll
    for (int s = 4; s < 6; ++s) { st[0] = ATT_MMA(ke[2 * (s - 4)], qf[s], st[0], 0, 0, 0); st[1] = ATT_MMA(ke[2 * (s - 4) + 1], qf[s], st[1], 0, 0, 0); }
#undef ATT_KF
}
template <int MODE>
__device__ __forceinline__ void attn_pv(const LAS unsigned char* vb_, f32x16 (&st)[2], f32x16 (&ot)[2], float& mrun, float& lsum, const int ql, const int hf, const int lane) {
    if (MODE != 1) {
    float mx = max3f(st[0][0], st[1][0], st[0][1]), my = max3f(st[1][1], st[0][2], st[1][2]);
#pragma unroll
    for (int i = 3; i < 15; i += 2) { mx = max3f(mx, st[0][i], st[1][i]); my = max3f(my, st[0][i + 1], st[1][i + 1]); }
    mx = max3f(mx, st[0][15], st[1][15]); mx = max3f(mx, my, my);
    if (__builtin_amdgcn_ballot_w64(mx > mrun + 8.0f) != 0ull) {
        mx = fmaxf(mx, shx32(mx, lane));
        const float mnew = (mx > mrun + 8.0f) ? mx : mrun;
        const float alpha = fexp2(mrun - mnew);
        mrun = mnew; lsum *= alpha;
#pragma unroll
        for (int i = 0; i < 16; ++i) { ot[0][i] *= alpha; ot[1][i] *= alpha; }
    }
    float ps = 0.f;
#pragma unroll
    for (int kb = 0; kb < 2; ++kb)
#pragma unroll
        for (int i = 0; i < 16; ++i) { const float p = fexp2(st[kb][i] - mrun); st[kb][i] = p; ps += p; }
    lsum += ps;
    } else lsum += st[0][0];
#pragma unroll
    for (int kb = 0; kb < 2; ++kb)
#pragma unroll
        for (int sI = 0; sI < 2; ++sI) {
            u32x4 pw = {pk_bf16(st[kb][8 * sI + 0], st[kb][8 * sI + 1]), pk_bf16(st[kb][8 * sI + 2], st[kb][8 * sI + 3]),
                        pk_bf16(st[kb][8 * sI + 4], st[kb][8 * sI + 5]), pk_bf16(st[kb][8 * sI + 6], st[kb][8 * sI + 7])};
            const bf16x8 pf = __builtin_bit_cast(bf16x8, pw);
#pragma unroll
            for (int db = 0; db < 2; ++db) {
                const LAS unsigned char* vp = vb_ + (db * 32 + ql) * VROW + (kb * 32 + 16 * sI + 4 * hf) * 2;
                const u32x2 v0 = *(const LAS u32x2*)vp, v1 = *(const LAS u32x2*)(vp + 16);
                u32x4 vw = {v0[0], v0[1], v1[0], v1[1]};
                ot[db] = att_mma<MODE>(__builtin_bit_cast(bf16x8, vw), pf, ot[db]);
            }
        }
}

template <int MODE>
__device__ __forceinline__ void attn_phase(const Args& a, bool do_ctx, LAS unsigned char* lds, const int wid_s) {
    const int tid = mk_tid(wid_s);
    const int lane = tid & 63, wid = wid_s, ql = lane & 31, hf = lane >> 5, G = gridDim.x;
    const bf16_t* Q = (const bf16_t*)(a.ws + WS_Q); const bf16_t* KN = (const bf16_t*)(a.ws + WS_KN); const bf16_t* KR = (const bf16_t*)(a.ws + WS_KR);
    const bf16_t* VT = (const bf16_t*)(a.ws + WS_VT); bf16_t* AC = (bf16_t*)(a.ws + WS_AC);
    const int nitems = 1024 + (do_ctx ? 32 : 0);
    LAS unsigned char* const ldsv = lds + 2 * KBUF;
    for (int it = 0;; ++it) {
        const long L = (long)it * G + blockIdx.x; if (L >= nitems) break;
        int b, h, qt, nkt;
        if (L < 1024) { const int x = (int)(L % 8), q = (int)((L / 8) % 32), bh = (int)(L / 256) * 8 + x; b = bh >> 3; h = bh & 7; qt = q + 1; nkt = RPB / 64; }
        else { const int bh = (int)(L - 1024); b = bh >> 3; h = bh & 7; qt = 0; nkt = CTXL / 64; }
        const int rowbase = b * RPB;
        const int qrow = rowbase + qt * 256 + wid * 32 + ql;
        bf16x8 qf[6];
#pragma unroll
        for (int s = 0; s < 6; ++s) qf[s] = *(const bf16x8*)(Q + (size_t)qrow * 768 + h * 96 + s * 16 + hf * 8);
        const bf16_t* gkn = KN + ((size_t)(rowbase + (tid >> 3))) * 512 + h * 64 + (tid & 7) * 8;
        const bf16_t* gkr = KR + ((size_t)(rowbase + ((tid & 255) >> 2))) * 32 + (tid & 3) * 8;
        const bf16_t* gvt = VT + ((size_t)((b * NH + h) * 64 + (tid >> 3))) * RPB + (tid & 7) * 8;
        const unsigned skn = (unsigned)((tid >> 3) * KROW + (tid & 7) * 16);
        const unsigned skr = (unsigned)(((tid & 255) >> 2) * KROW + 128 + (tid & 3) * 16);
        const unsigned svt = (unsigned)((tid >> 3) * VROW + (tid & 7) * 16);
#define ATT_LOADK(rk, rr, kt_) do { if (MODE == 3 && (kt_) > 1) break; rk = *(const u32x4*)(gkn + (size_t)(kt_) * 64 * 512); rr = *(const u32x4*)(gkr + (size_t)(kt_) * 64 * 32); } while (0)
#define ATT_LOADV(rv, kt_) do { if (MODE == 3 && (kt_) > 1) break; rv = *(const u32x4*)(gvt + (size_t)(kt_) * 64); } while (0)
#define ATT_WRITEK(rk, rr, buf) do { LAS unsigned char* nb_ = lds + (buf) * KBUF; *(LAS u32x4*)(nb_ + skn) = rk; if (tid < 256) *(LAS u32x4*)(nb_ + skr) = rr; } while (0)
#define ATT_WRITEV(rv, buf) do { LAS u32x2* p_ = (LAS u32x2*)(ldsv + (buf) * VBUF + svt); u32x2 lo_ = {rv[0], rv[1]}, hi_ = {rv[2], rv[3]}; p_[0] = lo_; p_[1] = hi_; } while (0)
        u32x4 kK, kR, vV;
        ATT_LOADK(kK, kR, 0); ATT_LOADV(vV, 0);
        ATT_WRITEK(kK, kR, 0); ATT_WRITEV(vV, 0);
        ATT_LOADK(kK, kR, 1);
        ATT_WRITEK(kK, kR, 1);
        __syncthreads();
        f32x16 ot[2], sa[2], sb[2];
#pragma unroll
        for (int i = 0; i < 16; ++i) { ot[0][i] = 0.f; ot[1][i] = 0.f; }
        float mrun = -3.0e38f, lsum = 0.f;
        attn_qk<MODE>(lds, qf, sa, ql, hf);
        __syncthreads();
        for (int t = 0; t < nkt; t += 2) {
            if (t + 2 < nkt) ATT_LOADK(kK, kR, t + 2);
            ATT_LOADV(vV, t + 1);
            attn_qk<MODE>(lds + KBUF, qf, sb, ql, hf);
            __builtin_amdgcn_sched_barrier(0);
            attn_pv<MODE>(ldsv, sa, ot, mrun, lsum, ql, hf, lane);
            if (t + 2 < nkt) ATT_WRITEK(kK, kR, 0);
            ATT_WRITEV(vV, 1);
            __syncthreads();
            if (t + 3 < nkt) ATT_LOADK(kK, kR, t + 3);
            if (t + 2 < nkt) ATT_LOADV(vV, t + 2);
            if (t + 2 < nkt) attn_qk<MODE>(lds, qf, sa, ql, hf);
            __builtin_amdgcn_sched_barrier(0);
            attn_pv<MODE>(ldsv + VBUF, sb, ot, mrun, lsum, ql, hf, lane);
            if (t + 3 < nkt) ATT_WRITEK(kK, kR, 1);
            if (t + 2 < nkt) ATT_WRITEV(vV, 0);
            __syncthreads();
        }
#undef ATT_LOADK
#undef ATT_LOADV
#undef ATT_WRITEK
#undef ATT_WRITEV
        const float ltot = lsum + shx32(lsum, lane);
        const float inv = 1.0f / ltot;
        bf16_t* orow = AC + (size_t)qrow * 1024 + h * 64;
#pragma unroll
        for (int db = 0; db < 2; ++db)
#pragma unroll
            for (int g = 0; g < 4; ++g) {
                u32x2 o = {pk_bf16(ot[db][4 * g + 0] * inv, ot[db][4 * g + 1] * inv), pk_bf16(ot[db][4 * g + 2] * inv, ot[db][4 * g + 3] * inv)};
                if (MODE == 0 || (o[0] == 0x12345678u && o[1] == 0x9abcdef1u)) *(u32x2*)(orow + db * 32 + 8 * g + 4 * hf) = o;
            }
    }
}

__global__ void __launch_bounds__(NTHREADS, 2) mk_fwd(Args a) {
    extern __shared__ __attribute__((aligned(16))) unsigned char lds[];
    cg::grid_group grid = cg::this_grid();
    LAS unsigned char* ldsl = (LAS unsigned char*)lds;
    const int G = gridDim.x, bid = blockIdx.x;
    const int wid_s = __builtin_amdgcn_readfirstlane((int)(threadIdx.x >> 6));
    unsigned char* ws = a.ws;
    unsigned* gbar = (unsigned*)(ws + WS_CTL) + 128; unsigned gep = 0;

    REP(2) if (PH & 1) p0_phase(a, lds, wid_s);
    __threadfence();
    grid.sync();
    if (PH & 2) p1_phase(a, wid_s);
    gsync(gbar, ++gep, wid_s);

    for (int l = 0; l < DEPTH; ++l) {
        if (DUP & 128) { for (int q_ = 0; q_ < 20; ++q_) gsync(gbar, ++gep, wid_s); }
        REP(3) if (PH & 4) {
            pg8::SchedDense S{(const char*)(ws + WS_HB), (size_t)256 * 1024 * 2, (const char*)(ws + WS_WTIN) + (size_t)l * INWP * 1024 * 2, (size_t)256 * 1024 * 2, MR / 256, INWP / 256, G, bid, 0};
            EpiInproj E{(bf16_t*)(ws + WS_P), a.in[7] + (size_t)l * INW};
            pg8::gemm_phase(ldsl, 1024, 1024, S, E, wid_s);
        }
        if (DUP & 2048) {
            pg8::SchedDense S{(const char*)(ws + WS_HB), (size_t)256 * 1024 * 2, (const char*)(ws + WS_WTIN) + (size_t)l * INWP * 1024 * 2, (size_t)256 * 1024 * 2, MR / 256, INWP / 256, G, bid, 0};
            EpiNone E{(float*)(ws + WS_GWS)};
            pg8::gemm_phase(ldsl, 1024, 1024, S, E, wid_s);
        }
        if (DUP & 4096) {
            pg8::SchedDense S{(const char*)(ws + WS_HB), (size_t)256 * 1024 * 2, (const char*)(ws + WS_WTIN) + (size_t)l * INWP * 1024 * 2, (size_t)256 * 1024 * 2, MR / 256, INWP / 256, G, bid, 2};
            EpiNone E{(float*)(ws + WS_GWS)};
            pg8::gemm_phase(ldsl, 1024, 1024, S, E, wid_s);
        }
        gsync(gbar, ++gep, wid_s);
        REP(6) if (PH & 8) rowa_phase(a, l, wid_s);
        gsync(gbar, ++gep, wid_s);
        if (PH & 16) {
            const bool lastl = (l == DEPTH - 1);
            pg8::SchedQKV S{(const char*)(ws + WS_P), (const char*)(ws + WS_WTUQ) + (size_t)l * 768 * 256 * 2, (const char*)(ws + WS_P) + OFF_KV * 2, (const char*)(ws + WS_WTUKV) + (size_t)l * 1024 * 256 * 2,
                            (size_t)256 * INWP * 2, (size_t)256 * 256 * 2, lastl ? 128 : MR / 256, lastl ? 1 : 0, G, bid};
            EpiQKV E{EpiQ{(bf16_t*)(ws + WS_Q), (const float*)(ws + WS_RSQ), (const float2*)(ws + WS_ROPE)}, EpiKV{(bf16_t*)(ws + WS_KN), (bf16_t*)(ws + WS_VT), (const float*)(ws + WS_RSKV)}};
            pg8::gemm_phase(ldsl, 256, INWP, S, E, wid_s);
        }
        gsync(gbar, ++gep, wid_s);
        if (PH & 64) attn_phase<0>(a, l < DEPTH - 1, ldsl, wid_s);
        if (DUP & 1) attn_phase<AMODE>(a, l < DEPTH - 1, ldsl, wid_s);
        gsync(gbar, ++gep, wid_s);
        REP(5) {
        if (PH & 128) {
            pg8::SchedDense S{(const char*)(ws + WS_AC), (size_t)256 * 1024 * 2, (const char*)(ws + WS_WTOAB) + (size_t)l * 1024 * 1024 * 2, (size_t)256 * 512 * 2, (l == DEPTH - 1) ? 128 : MR / 256, 4, G, bid, (l == DEPTH - 1) ? 1 : 0};
            EpiMergeA E{(bf16_t*)(ws + WS_MG), (const bf16_t*)(ws + WS_P)};
            pg8::gemm_phase(ldsl, 512, 1024, S, E, wid_s);
        }
        if (PH & 128) {
            pg8::SchedDense S{(const char*)(ws + WS_AC) + 512 * 2, (size_t)256 * 1024 * 2, (const char*)(ws + WS_WTOAB) + (size_t)l * 1024 * 1024 * 2 + (size_t)1024 * 512 * 2, (size_t)256 * 512 * 2, (l == DEPTH - 1) ? 128 : MR / 256, 4, G, bid, (l == DEPTH - 1) ? 1 : 0};
            EpiMergeB E{(bf16_t*)(ws + WS_MG), (const bf16_t*)(ws + WS_P)};
            pg8::gemm_phase(ldsl, 512, 1024, S, E, wid_s);
        }
        }
        gsync(gbar, ++gep, wid_s);
        for (int rep_ = 0; rep_ <= (((DUP >> 8) & 1) && l == 0 ? 1 : 0); ++rep_) if (PH & 256) {
            pg8::SchedDense S{(const char*)(ws + WS_MG), (size_t)256 * 1024 * 2, (const char*)(ws + WS_WTO) + (size_t)l * 1024 * 1024 * 2, (size_t)256 * 1024 * 2, (l == DEPTH - 1) ? 128 : MR / 256, 4, G, bid, (l == DEPTH - 1) ? 1 : 0};
            EpiOut E{(float*)(ws + WS_RES), a.in[0], a.in[2], (const float*)(ws + WS_MOD) + (size_t)l * 5 * 6144, l};
            pg8::gemm_phase(ldsl, 1024, 1024, S, E, wid_s);
        }
        gsync(gbar, ++gep, wid_s);
        if (PH & 512) ln1_router_phase(a, l, lds, wid_s);
        gsync(gbar, ++gep, wid_s);
        REP(6) if (PH & 1024) gather_phase(a, l, lds, wid_s);
        gsync(gbar, ++gep, wid_s);
        REP(1) if (PH & 2048) {
            moe_prefix(a, l, lds, wid_s);
            const LAS int* ts = (const LAS int*)(ldsl + MISC_OFF);
            const int TM = ts[32];
            pg8::SchedMoe S{(const char*)(ws + WS_HB), (size_t)0, (const char*)(ws + WS_WTGU) + (size_t)l * NEXP * 2048 * 1024 * 2, (size_t)2048 * 1024 * 2, (size_t)256 * 1024 * 2, TM, 8, G, bid, ts};
            EpiGU E{(bf16_t*)(ws + WS_ACT), a.in[25] + (size_t)l * NEXP * 2048};
            {
                const int tid = mk_tid(wid_s); const int* RO = (const int*)(ws + WS_ROWOFF); LAS int* tab = (LAS int*)(ldsl + GTAB_OFF);
                pg8::Unit uu;
                for (int i = 0; i < 27 && S.next(i, uu); ++i) if (tid < 256) tab[i * 256 + tid] = RO[uu.pm * 256 + tid];
                __syncthreads();
            }
            pg8::gemm_phase<EpiGU, pg8::SchedMoe, true>(ldsl, 1024, 1024, S, E, wid_s, (const LAS int*)(ldsl + GTAB_OFF));
        }
        gsync(gbar, ++gep, wid_s);
        REP(1) if (PH & 4096) {
            const LAS int* ts = (const LAS int*)(ldsl + MISC_OFF);
            const int TM = ts[32];
            pg8::SchedMoe S{(const char*)(ws + WS_ACT), (size_t)256 * 1024 * 2, (const char*)(ws + WS_WTDN) + (size_t)l * NEXP * 1024 * 1024 * 2, (size_t)1024 * 1024 * 2, (size_t)256 * 1024 * 2, TM, 4, G, bid, ts};
            EpiDown E{(bf16_t*)(ws + WS_AS), a.in[27] + (size_t)l * NEXP * 1024, (const float*)(ws + WS_GWS)};
            pg8::gemm_phase(ldsl, 1024, 1024, S, E, wid_s);
        }
        gsync(gbar, ++gep, wid_s);
        for (int rep_ = 0; rep_ <= (((DUP >> 9) & 1) && l == DEPTH - 1 ? 1 : 0); ++rep_) if (PH & 8192) ln2_phase(a, l, wid_s);
        if (l + 1 < DEPTH) gsync(gbar, ++gep, wid_s);
    }
}

extern "C" void kernel_launch(void* const* d_in, const int* in_sizes, int n_in, void* d_out, int out_size, void* d_ws, size_t ws_size, hipStream_t stream) {
    static int grid = 0;
    if (grid == 0) {
        int dev = 0, cus = 0, per_cu = 0;
        if (hipGetDevice(&dev) != hipSuccess || hipDeviceGetAttribute(&cus, hipDeviceAttributeMultiprocessorCount, dev) != hipSuccess) { fprintf(stderr, "kernel_launch: device query failed\n"); grid = -1; return; }
        if (n_in != 28 || ws_size < WS_END) { fprintf(stderr, "kernel_launch: need 28 inputs and %zu B workspace; got %d, %zu\n", (size_t)WS_END, n_in, ws_size); grid = -1; return; }
        if (hipFuncSetAttribute((const void*)mk_fwd, hipFuncAttributeMaxDynamicSharedMemorySize, LDS_BYTES) != hipSuccess) { fprintf(stderr, "kernel_launch: hipFuncSetAttribute failed\n"); grid = -1; return; }
        if (hipOccupancyMaxActiveBlocksPerMultiprocessor(&per_cu, (const void*)mk_fwd, NTHREADS, LDS_BYTES) != hipSuccess || per_cu < 1) { fprintf(stderr, "kernel_launch: occupancy query says %d\n", per_cu); per_cu = 1; }
        (void)hipGetLastError();
        grid = cus;
        if (grid > 256) grid = 256;
        grid &= ~7;
    }
    if (grid <= 0) return;
    Args a{};
    for (int i = 0; i < 28; ++i) a.in[i] = (const float*)d_in[i];
    a.out = (float*)d_out; a.ws = (unsigned char*)d_ws;
    void* args[] = {&a};
    hipError_t e = hipLaunchCooperativeKernel((const void*)mk_fwd, dim3(grid), dim3(NTHREADS), args, LDS_BYTES, stream);
    if (e != hipSuccess) fprintf(stderr, "kernel_launch: cooperative launch failed: %s (grid %d)\n", hipGetErrorString(e), grid);
}
```

```cpp
#include <hip/hip_runtime.h>
#include <hip/hip_cooperative_groups.h>
#include <cstdio>
namespace cg = cooperative_groups;

#define LAS __attribute__((address_space(3)))
typedef unsigned short bf16_t;
typedef short bf16x8 __attribute__((ext_vector_type(8)));
typedef short bf16x4 __attribute__((ext_vector_type(4)));
typedef float f32x4 __attribute__((ext_vector_type(4)));
typedef float f32x16 __attribute__((ext_vector_type(16)));
typedef float f32x8 __attribute__((ext_vector_type(8)));
typedef float f32x2 __attribute__((ext_vector_type(2)));
typedef unsigned u32x4 __attribute__((ext_vector_type(4)));
typedef unsigned u32x2 __attribute__((ext_vector_type(2)));

constexpr int D = 1024, NBATCH = 4, SEQ = 8192, CTXL = 256, RPB = SEQ + CTXL, MR = NBATCH * RPB;
constexpr int DEPTH = 2, NH = 8, INW = 4000, INWP = 4096, NEXP = 32;
constexpr int OFF_KV = 256, OFF_KR = 384, OFF_CX = 416, OFF_CB = 928, OFF_CC = 1440, OFF_GA = 1952, OFF_GB = 2976;
constexpr float NORM_EPS = 1e-6f, DN_ALPHA = 1.41421356237f, SW_LIMIT = 7.0f, SW_ALPHA = 1.702f;
constexpr float QSCALE = 0.10206207261596575f * 1.4426950408889634f;
constexpr int SLOT_CAP = 143360;
constexpr int NTHREADS = 512;
constexpr int LDS_BYTES = 156 * 1024, MISC_OFF = 128 * 1024, GTAB_OFF = MISC_OFF + 1024;

constexpr size_t WS_CTL = 0;
constexpr size_t WS_MOD = 4096;
constexpr size_t WS_ROPE = WS_MOD + (size_t)DEPTH * 5 * 6144 * 4;
constexpr size_t WS_RSQ = WS_ROPE + (size_t)SEQ * 16 * 8;
constexpr size_t WS_RSKV = WS_RSQ + (size_t)MR * 4;
constexpr size_t WS_RE = WS_RSKV + (size_t)MR * 4;
constexpr size_t WS_RPOS = WS_RE + (size_t)MR * 16;
constexpr size_t WS_RG = WS_RPOS + (size_t)MR * 16;
constexpr size_t WS_SLOTOF = WS_RG + (size_t)MR * 16;
constexpr size_t WS_GWS = WS_SLOTOF + (size_t)MR * 16;
constexpr size_t WS_ROWOFF = WS_GWS + (size_t)SLOT_CAP * 4;
constexpr size_t WS_WTIN = WS_ROWOFF + (size_t)SLOT_CAP * 4;
constexpr size_t WS_WTUQ = WS_WTIN + (size_t)DEPTH * INWP * 1024 * 2;
constexpr size_t WS_WTUKV = WS_WTUQ + (size_t)DEPTH * 768 * 256 * 2;
constexpr size_t WS_WTOAB = WS_WTUKV + (size_t)DEPTH * 1024 * 256 * 2;
constexpr size_t WS_WTO = WS_WTOAB + (size_t)DEPTH * 1024 * 1024 * 2;
constexpr size_t WS_WTGU = WS_WTO + (size_t)DEPTH * 1024 * 1024 * 2;
constexpr size_t WS_WTDN = WS_WTGU + (size_t)DEPTH * NEXP * 2048 * 1024 * 2;
constexpr size_t WS_HB = WS_WTDN + (size_t)DEPTH * NEXP * 1024 * 1024 * 2;
constexpr size_t WS_P = WS_HB + (size_t)MR * 1024 * 2;
constexpr size_t WS_Q = WS_P + (size_t)MR * INWP * 2;
constexpr size_t WS_KN = WS_Q + (size_t)MR * 768 * 2;
constexpr size_t WS_KR = WS_KN + (size_t)MR * 512 * 2;
constexpr size_t WS_VT = WS_KR + (size_t)MR * 32 * 2;
constexpr size_t WS_AC = WS_VT + (size_t)MR * 512 * 2;
constexpr size_t WS_MG = WS_AC + (size_t)MR * 1024 * 2;
constexpr size_t WS_RES = WS_MG + (size_t)MR * 1024 * 2;
constexpr size_t WS_AS = WS_RES + (size_t)MR * 1024 * 4;
constexpr size_t WS_ACT = WS_AS + (size_t)SLOT_CAP * 1024 * 2;
constexpr size_t WS_END = WS_ACT + (size_t)SLOT_CAP * 1024 * 2;

#ifndef PH
#define PH 0xffff
#endif
#ifndef DUP
#define DUP 0
#endif
#ifndef AMODE
#define AMODE 0
#endif
#define REP(k) for (int rep_ = 0; rep_ <= ((DUP >> (k)) & 1); ++rep_)
struct Args { const float* in[28]; float* out; unsigned char* ws; };

__device__ __forceinline__ int lane_id() { int l; asm volatile("v_mbcnt_lo_u32_b32 %0, -1, 0\n\tv_mbcnt_hi_u32_b32 %0, -1, %0" : "=v"(l)); return l; }
__device__ __forceinline__ int mk_tid(int wid_s) { return wid_s * 64 + lane_id(); }
template <int M> __device__ __forceinline__ float swz(float v) { return __int_as_float(__builtin_amdgcn_ds_swizzle(__float_as_int(v), (M << 10) | 0x1f)); }
__device__ __forceinline__ float shx32(float v, int lane) { return __int_as_float(__builtin_amdgcn_ds_bpermute((lane ^ 32) << 2, __float_as_int(v))); }
__device__ __forceinline__ void gsync(unsigned* bar, unsigned epoch, int wid_s) {
    asm volatile("s_waitcnt vmcnt(0)" ::: "memory");
    __syncthreads();
    if (wid_s == 0) {
        if (lane_id() == 0) {
            __builtin_amdgcn_fence(__ATOMIC_RELEASE, "agent");
            const unsigned per = gridDim.x >> 3;
            const unsigned old = __hip_atomic_fetch_add(bar + 32u * (1u + (blockIdx.x & 7u)), 1u, __ATOMIC_RELAXED, __HIP_MEMORY_SCOPE_AGENT);
            if (old + 1u == epoch * per) __hip_atomic_fetch_add(bar, 1u, __ATOMIC_RELAXED, __HIP_MEMORY_SCOPE_AGENT);
            while (__hip_atomic_load(bar, __ATOMIC_RELAXED, __HIP_MEMORY_SCOPE_AGENT) < epoch * 8u) __builtin_amdgcn_s_sleep(1);
            __builtin_amdgcn_fence(__ATOMIC_ACQUIRE, "agent");
        }
    }
    __syncthreads();
}
__device__ __forceinline__ unsigned pk_bf16(float lo, float hi) { unsigned r; asm("v_cvt_pk_bf16_f32 %0, %1, %2" : "=v"(r) : "v"(lo), "v"(hi)); return r; }
__device__ __forceinline__ float bf_lo(unsigned u) { return __uint_as_float(u << 16); }
__device__ __forceinline__ float bf_hi(unsigned u) { return __uint_as_float(u & 0xffff0000u); }
__device__ __forceinline__ float bf2f(bf16_t b) { return __uint_as_float(((unsigned)b) << 16); }
__device__ __forceinline__ float fexp2(float x) { return __builtin_amdgcn_exp2f(x); }
__device__ __forceinline__ float frcp(float x) { return __builtin_amdgcn_rcpf(x); }
__device__ __forceinline__ float sigmoidf_(float x) { return frcp(1.0f + fexp2(-1.4426950408889634f * x)); }
__device__ __forceinline__ float max3f(float a, float b, float c) { float d; asm("v_max3_f32 %0, %1, %2, %3" : "=v"(d) : "v"(a), "v"(b), "v"(c)); return d; }
__device__ __forceinline__ float wave_sum(float v, int lane) {
    v += shx32(v, lane); v += swz<16>(v); v += swz<8>(v); v += swz<4>(v); v += swz<2>(v); v += swz<1>(v);
    return v;
}

namespace pg8 {
constexpr int BM = 256, BK = 64, HALF = 128, HTB = HALF * BK * 2;
__device__ __forceinline__ int lds_byte(int r, int c) { const int st = (r >> 4) * 2 + (c >> 5), rr = r & 15, cc = c & 31, ob = rr * 64 + cc * 2; return st * 1024 + (ob ^ (((ob >> 9) & 1) << 5)); }
__device__ __forceinline__ void stage_rc(int b, int& R, int& C) { const int st = b / 1024, sb = b % 1024, swz = sb ^ (((sb >> 9) & 1) << 5); R = (st >> 1) * 16 + swz / 64; C = (st & 1) * 32 + (swz % 64) / 2; }
__device__ __forceinline__ int perm32(int rho) { const int n = rho >> 4, i = rho & 15; return 8 * (i >> 2) + 4 * n + (i & 3); }

struct Unit { const char* A; const char* B; int pm, pn, e; };

__device__ __forceinline__ bool unit_coords(unsigned L, int nM, int nN, int& pm, int& pn) {
    const unsigned total = (unsigned)nM * (unsigned)nN; if (L >= total) return false;
    const unsigned fullg = (unsigned)nM >> 3, full = fullg * 8u * (unsigned)nN;
    if (L < full) {
        const unsigned x = L & 7u, q = L >> 3;
        if (nN == 16 && (fullg & 7u) == 0u) {
            const unsigned blk = q >> 5, in = q & 31u;
            pn = (int)((blk & 3u) * 4u + (in & 3u)); pm = (int)(((blk >> 2) * 8u + (in >> 2)) * 8u + x);
        } else { const unsigned qd = q / (unsigned)nN; pn = (int)(q - qd * (unsigned)nN); pm = (int)(qd * 8u + x); }
    }
    else { const unsigned r = (unsigned)nM & 7u, Lp = L - full; const unsigned qd = Lp / r; pm = (int)(fullg * 8u + (Lp - qd * r)); pn = (int)qd; }
    return true;
}
struct SchedDense {
    const char* A; size_t a_tstep; const char* B; size_t b_tstep; int nM, nN, G, c, skipctx;
    __device__ __forceinline__ bool next(int i, Unit& u) const {
        int pm, pn; if (!unit_coords((unsigned)(i * G + c), nM, nN, pm, pn)) return false;
        if (skipctx == 1) pm += (pm >> 5) + 1;
        if (skipctx == 2) { pm = 0; pn = 0; }
        u.pm = pm; u.pn = pn; u.e = 0; u.A = A + (size_t)pm * a_tstep; u.B = B + (size_t)pn * b_tstep; return true;
    }
};
struct SchedQKV {
    const char* Aq; const char* Bq; const char* Akv; const char* Bkv; size_t a_tstep, b_tstep; int nMq, skipq, G, c;
    __device__ __forceinline__ bool next(int i, Unit& u) const {
        const unsigned L = (unsigned)(i * G + c), nQ = (unsigned)nMq * 3u;
        int pm, pn;
        if (L < nQ) { unit_coords(L, nMq, 3, pm, pn); if (skipq) pm += (pm >> 5) + 1; u.e = 0; u.A = Aq + (size_t)pm * a_tstep; u.B = Bq + (size_t)pn * b_tstep; }
        else { if (!unit_coords(L - nQ, MR / 256, 4, pm, pn)) return false; u.e = 1; u.A = Akv + (size_t)pm * a_tstep; u.B = Bkv + (size_t)pn * b_tstep; }
        u.pm = pm; u.pn = pn; return true;
    }
};
struct SchedMoe {
    const char* A; size_t a_tstep; const char* W; size_t w_estep, b_tstep; int nM, nN, G, c; const LAS int* tstart;
    __device__ __forceinline__ bool next(int i, Unit& u) const {
        int pm, pn; if (!unit_coords((unsigned)(i * G + c), nM, nN, pm, pn)) return false;
        int e = 0;
#pragma unroll 1
        for (int k = 16; k >= 1; k >>= 1) if (tstart[e + k] <= pm) e += k;
        u.pm = pm; u.pn = pn; u.e = e; u.A = A + (size_t)pm * a_tstep; u.B = W + (size_t)e * w_estep + (size_t)pn * b_tstep; return true;
    }
};

typedef f32x4 Acc[2][2][4][2];

template <class Epi, class Sched, bool GATHER = false>
__device__ __forceinline__ void gemm_phase(LAS unsigned char* lds, const int K, const int lda, const Sched& S, const Epi& E, const int wid_s, const LAS int* rowoff = nullptr) {
    const int tid = mk_tid(wid_s);
    const int wid = wid_s, lane = tid & 63, wr = wid >> 2, wc = wid & 3, fr = lane & 15, fq = lane >> 4;
    const int nt = K / BK;
    unsigned voffA[2], voffB[2];
#pragma unroll
    for (int i = 0; i < 2; ++i) { int R, C; stage_rc(tid * 16 + i * 8192, R, C); const int Rb = (R & ~31) + perm32(R & 31);
        voffA[i] = (unsigned)(R * lda + C) * 2u; voffB[i] = (unsigned)(Rb * K + C) * 2u; }
    const size_t kstep = (size_t)(BK * 2);
    const size_t hstepA = GATHER ? (size_t)0 : (size_t)HALF * lda * 2, hstepB = (size_t)HALF * K * 2;
    int gR[2], gC[2];
#pragma unroll
    for (int i = 0; i < 2; ++i) stage_rc(tid * 16 + i * 8192, gR[i], gC[i]);
    unsigned gcur[2][2], gnxt[2][2];
#define PG8_GLOAD(dst, pm_) do { _Pragma("unroll") for (int h_ = 0; h_ < 2; ++h_) _Pragma("unroll") for (int i_ = 0; i_ < 2; ++i_) dst[h_][i_] = (unsigned)rowoff[(pm_) * 256 + h_ * 128 + gR[i_]] + (unsigned)gC[i_] * 2u; } while (0)
    const unsigned ldsw = (unsigned)wid * 1024u;
    const int aoff = lds_byte(wr * 64 + fr, fq * 8), boff = lds_byte(wc * 32 + fr, fq * 8);
#define PG8_SA(b, h) (((b) * 2 + (h)) * HTB)
#define PG8_SB(b, h) ((4 + (b) * 2 + (h)) * HTB)
#define PG8_STAGE(bufoff, gbase, voff) do { const char* _gb = (const char*)(gbase); asm volatile("" : "+s"(_gb)); _Pragma("unroll") for (int _i = 0; _i < 2; ++_i) \
        __builtin_amdgcn_global_load_lds((const unsigned*)(_gb + (voff)[_i]), (LAS unsigned*)(lds + (bufoff) + ldsw + _i * 8192), 16, 0, 0); } while (0)
#define PG8_STAGEA(bufoff, gbase, h_, usenext) do { if (GATHER) { unsigned go_[2] = {(usenext) ? gnxt[h_][0] : gcur[h_][0], (usenext) ? gnxt[h_][1] : gcur[h_][1]}; PG8_STAGE(bufoff, gbase, go_); } else PG8_STAGE(bufoff, (gbase) + (h_) * hstepA, voffA); } while (0)
#define PG8_LDA(dst, b, h) do { _Pragma("unroll") for (int m = 0; m < 4; ++m) _Pragma("unroll") for (int k = 0; k < 2; ++k) dst[m][k] = *(const LAS bf16x8*)(lds + PG8_SA(b, h) + aoff + m * 2048 + k * 1024); } while (0)
#define PG8_LDB(dst, b, h) do { _Pragma("unroll") for (int n = 0; n < 2; ++n) _Pragma("unroll") for (int k = 0; k < 2; ++k) dst[n][k] = *(const LAS bf16x8*)(lds + PG8_SB(b, h) + boff + n * 2048 + k * 1024); } while (0)
#define PG8_MMA(ai, bj, At, Bt) do { __builtin_amdgcn_s_setprio(1); _Pragma("unroll") for (int m = 0; m < 4; ++m) _Pragma("unroll") for (int n = 0; n < 2; ++n) _Pragma("unroll") for (int k = 0; k < 2; ++k) \
        acc[ai][bj][m][n] = __builtin_amdgcn_mfma_f32_16x16x32_bf16(Bt[n][k], At[m][k], acc[ai][bj][m][n], 0, 0, 0); __builtin_amdgcn_s_setprio(0); } while (0)
#define PG8_WAIT_V(n) asm volatile("s_waitcnt vmcnt(" #n ")" ::: "memory")
#define PG8_WAIT_L(n) asm volatile("s_waitcnt lgkmcnt(" #n ")" ::: "memory")
#define PG8_BAR __builtin_amdgcn_s_barrier()
#define PG8_SCHED __builtin_amdgcn_sched_barrier(0)
    Unit cur, nxt; int ui = 0;
    if (!S.next(0, cur)) return;
    Acc acc;
#pragma unroll
    for (int a = 0; a < 2; ++a)
#pragma unroll
        for (int b = 0; b < 2; ++b)
#pragma unroll
            for (int m = 0; m < 4; ++m)
#pragma unroll
                for (int n = 0; n < 2; ++n) acc[a][b][m][n] = (f32x4){0.f, 0.f, 0.f, 0.f};
    bf16x8 At[4][2], B0[2][2], B1[2][2];
    const char* cA = cur.A; const char* cB = cur.B;
    if (GATHER) { PG8_GLOAD(gcur, 0); }
    PG8_STAGE(PG8_SB(0, 0), cB, voffB); PG8_STAGEA(PG8_SA(0, 0), cA, 0, false); PG8_STAGE(PG8_SB(0, 1), cB + hstepB, voffB); PG8_STAGEA(PG8_SA(0, 1), cA, 1, false);
    if (wr == 1) PG8_BAR;
    PG8_WAIT_V(4); PG8_BAR;
    PG8_STAGE(PG8_SB(1, 0), cB + kstep, voffB); PG8_STAGEA(PG8_SA(1, 0), cA + kstep, 0, false); PG8_STAGE(PG8_SB(1, 1), cB + hstepB + kstep, voffB);
    PG8_WAIT_V(6); PG8_BAR;
    for (;;) {
        const bool has_next = S.next(ui + 1, nxt);
        const char* nA = has_next ? nxt.A : cA; const char* nB = has_next ? nxt.B : cB;
        if (GATHER) { if (has_next) PG8_GLOAD(gnxt, ui + 1); else { _Pragma("unroll") for (int h_ = 0; h_ < 2; ++h_) _Pragma("unroll") for (int i_ = 0; i_ < 2; ++i_) gnxt[h_][i_] = gcur[h_][i_]; } }
#pragma unroll 1
        for (int t = 0; t < nt; t += 2) {
            const bool last = (t == nt - 2);
            const char* a1 = cA + (size_t)(t + 1) * kstep;
            const char* a2 = last ? nA : cA + (size_t)(t + 2) * kstep; const char* b2 = last ? nB : cB + (size_t)(t + 2) * kstep;
            const char* a3 = a2 + kstep; const char* b3 = b2 + kstep;
            PG8_LDB(B0, 0, 0); PG8_SCHED; PG8_LDA(At, 0, 0); PG8_STAGEA(PG8_SA(1, 1), a1, 1, false);
            PG8_WAIT_L(8); PG8_BAR; PG8_WAIT_L(0); PG8_MMA(0, 0, At, B0); PG8_BAR; PG8_SCHED;
            PG8_LDB(B1, 0, 1); PG8_STAGE(PG8_SB(0, 0), b2, voffB);
            PG8_BAR; PG8_WAIT_L(0); PG8_MMA(0, 1, At, B1); PG8_BAR;
            PG8_LDA(At, 0, 1); PG8_STAGEA(PG8_SA(0, 0), a2, 0, last);
            PG8_BAR; PG8_WAIT_L(0); PG8_MMA(1, 0, At, B0); PG8_BAR; PG8_SCHED;
            PG8_STAGE(PG8_SB(0, 1), b2 + hstepB, voffB);
            PG8_WAIT_V(6); PG8_BAR; PG8_MMA(1, 1, At, B1); PG8_BAR;
            PG8_LDB(B0, 1, 0); PG8_SCHED; PG8_LDA(At, 1, 0); PG8_STAGEA(PG8_SA(0, 1), a2, 1, last);
            PG8_WAIT_L(8); PG8_BAR; PG8_WAIT_L(0); PG8_MMA(0, 0, At, B0); PG8_BAR; PG8_SCHED;
            PG8_LDB(B1, 1, 1); PG8_STAGE(PG8_SB(1, 0), b3, voffB);
            PG8_BAR; PG8_WAIT_L(0); PG8_MMA(0, 1, At, B1); PG8_BAR;
            PG8_LDA(At, 1, 1); PG8_STAGEA(PG8_SA(1, 0), a3, 0, last);
            PG8_BAR; PG8_WAIT_L(0); PG8_MMA(1, 0, At, B0); PG8_BAR; PG8_SCHED;
            PG8_STAGE(PG8_SB(1, 1), b3 + hstepB, voffB);
            PG8_WAIT_V(6); PG8_BAR; PG8_MMA(1, 1, At, B1); PG8_BAR;
        }
        E(acc, cur, wr, wc, fr, fq);
        if (!has_next) break;
#pragma unroll
        for (int a = 0; a < 2; ++a)
#pragma unroll
            for (int b = 0; b < 2; ++b)
#pragma unroll
                for (int m = 0; m < 4; ++m)
#pragma unroll
                    for (int n = 0; n < 2; ++n) acc[a][b][m][n] = (f32x4){0.f, 0.f, 0.f, 0.f};
        cur = nxt; cA = nA; cB = nB; ++ui;
        if (GATHER) { _Pragma("unroll") for (int h_ = 0; h_ < 2; ++h_) _Pragma("unroll") for (int i_ = 0; i_ < 2; ++i_) gcur[h_][i_] = gnxt[h_][i_]; }
    }
    PG8_WAIT_V(0);
    if (wr == 0) PG8_BAR;
    PG8_BAR;
#undef PG8_SA
#undef PG8_SB
#undef PG8_STAGE
#undef PG8_LDA
#undef PG8_STAGEA
#undef PG8_GLOAD
#undef PG8_LDB
#undef PG8_MMA
#undef PG8_WAIT_V
#undef PG8_WAIT_L
#undef PG8_BAR
#undef PG8_SCHED
}
}
using pg8::Acc; using pg8::Unit;

#define EPI_ROW(u, ai, m) ((u).pm * 256 + (ai) * 128 + wr * 64 + (m) * 16 + fr)
#define EPI_COL(u, bj) ((u).pn * 256 + (bj) * 128 + wc * 32 + 8 * fq)

#define EPI_PIN(r) asm volatile("" : "+v"(r))
#define EPI_FOR_BJ _Pragma("unroll") for (int bj = 0; bj < 2; ++bj)
#define EPI_FOR_AM _Pragma("unroll") for (int ai = 0; ai < 2; ++ai) _Pragma("unroll") for (int m = 0; m < 4; ++m)
__device__ __forceinline__ u32x4 pack8(const f32x4 a, const f32x4 b) { u32x4 o = {pk_bf16(a[0], a[1]), pk_bf16(a[2], a[3]), pk_bf16(b[0], b[1]), pk_bf16(b[2], b[3])}; return o; }

struct EpiInproj {
    static constexpr bool MID = false;
    bf16_t* P; const float* bias;
    __device__ __forceinline__ void operator()(Acc& acc, const Unit& u, int wr, int wc, int fr, int fq) const {
        f32x4 b0[2], b1[2];
        EPI_FOR_BJ { const int c0 = EPI_COL(u, bj); b0[bj] = (f32x4){0.f, 0.f, 0.f, 0.f}; b1[bj] = b0[bj];
            if (c0 < INW) { b0[bj] = *(const f32x4*)(bias + c0); b1[bj] = *(const f32x4*)(bias + c0 + 4); } }
        EPI_FOR_BJ { const int c0 = EPI_COL(u, bj);
            EPI_FOR_AM { int r = EPI_ROW(u, ai, m); EPI_PIN(r);
                *(u32x4*)(P + (size_t)r * INWP + c0) = pack8(acc[ai][bj][m][0] + b0[bj], acc[ai][bj][m][1] + b1[bj]);
                __builtin_amdgcn_sched_barrier(0); } }
    }
};

struct EpiNone {
    static constexpr bool MID = false;
    float* dummy;
    __device__ __forceinline__ void operator()(Acc& acc, const Unit& u, int wr, int wc, int fr, int fq) const {
        float t = 0.f;
        EPI_FOR_BJ EPI_FOR_AM t += acc[ai][bj][m][0][0] + acc[ai][bj][m][1][3];
        if (t == 12345.678f) dummy[0] = t;
    }
};

struct EpiQ {
    static constexpr bool MID = false;
    bf16_t* Q; const float* rs; const float2* cs;
    __device__ __forceinline__ void operator()(Acc& acc, const Unit& u, int wr, int wc, int fr, int fq) const {
        const bool is_ctx = (u.pm % 33) == 0;
        float sc[2][4];
        EPI_FOR_AM { const int r = EPI_ROW(u, ai, m); sc[ai][m] = rs[r] * QSCALE; }
        EPI_FOR_BJ {
            const int grp = (u.pn * 256 + bj * 128 + wc * 32) >> 5;
            const bool rope = ((grp % 3) == 2) && !is_ctx;
            EPI_FOR_AM { int r = EPI_ROW(u, ai, m); EPI_PIN(r);
                acc[ai][bj][m][0] *= sc[ai][m]; acc[ai][bj][m][1] *= sc[ai][m];
                if (rope) {
                    const int t = (r % RPB) - CTXL;
                    const float2* c2 = cs + (size_t)t * 16 + (fq >> 1) * 8;
#pragma unroll
                    for (int e = 0; e < 8; ++e) {
                        const float v = acc[ai][bj][m][e >> 2][e & 3];
                        const float pv = swz<16>(v);
                        const float2 csv = c2[e];
                        acc[ai][bj][m][e >> 2][e & 3] = v * csv.x + ((fq & 1) ? pv : -pv) * csv.y;
                    }
                }
                __builtin_amdgcn_sched_barrier(0); } }
        EPI_FOR_BJ { const int c0 = EPI_COL(u, bj);
            EPI_FOR_AM { int r = EPI_ROW(u, ai, m); EPI_PIN(r);
                *(u32x4*)(Q + (size_t)r * 768 + c0) = pack8(acc[ai][bj][m][0], acc[ai][bj][m][1]);
                __builtin_amdgcn_sched_barrier(0); } }
    }
};

struct EpiKV {
    static constexpr bool MID = false;
    bf16_t* KN; bf16_t* VT; const float* rs;
    __device__ __forceinline__ void operator()(Acc& acc, const Unit& u, int wr, int wc, int fr, int fq) const {
        float sc[2][4];
        EPI_FOR_AM { const int r = EPI_ROW(u, ai, m); sc[ai][m] = rs[r]; }
        EPI_FOR_BJ { const int c0 = EPI_COL(u, bj);
            EPI_FOR_AM { int r = EPI_ROW(u, ai, m); EPI_PIN(r);
                const f32x4 v0 = acc[ai][bj][m][0] * sc[ai][m], v1 = acc[ai][bj][m][1] * sc[ai][m];
                if (u.pn < 2) *(u32x4*)(KN + (size_t)r * 512 + c0) = pack8(v0, v1);
                else {
                    const int da = c0 - 512, hh = da >> 6, d = da & 63, b = r / RPB, j = r % RPB;
                    bf16_t* base = VT + ((size_t)((b * NH + hh) * 64 + d)) * RPB + j;
                    const u32x4 pk = pack8(v0, v1);
#pragma unroll
                    for (int e = 0; e < 4; ++e) { base[(size_t)(2 * e) * RPB] = (bf16_t)(pk[e] & 0xffffu); base[(size_t)(2 * e + 1) * RPB] = (bf16_t)(pk[e] >> 16); }
                }
                __builtin_amdgcn_sched_barrier(0); } }
    }
};

struct EpiQKV {
    static constexpr bool MID = false;
    EpiQ q; EpiKV kv;
    __device__ __forceinline__ void operator()(Acc& acc, const Unit& u, int wr, int wc, int fr, int fq) const {
        if (u.e == 0) q(acc, u, wr, wc, fr, fq); else kv(acc, u, wr, wc, fr, fq);
    }
};

struct EpiMergeA {
    static constexpr bool MID = false;
    bf16_t* MG; const bf16_t* P;
    __device__ __forceinline__ void operator()(Acc& acc, const Unit& u, int wr, int wc, int fr, int fq) const {
        EPI_FOR_BJ { const int c0 = EPI_COL(u, bj);
            EPI_FOR_AM { int r = EPI_ROW(u, ai, m); EPI_PIN(r);
                const u32x4 ga = *(const u32x4*)(P + (size_t)r * INWP + OFF_GA + c0);
#pragma unroll
                for (int e = 0; e < 8; ++e) acc[ai][bj][m][e >> 2][e & 3] *= sigmoidf_((e & 1) ? bf_hi(ga[e >> 1]) : bf_lo(ga[e >> 1]));
                __builtin_amdgcn_sched_barrier(0); } }
        EPI_FOR_BJ { const int c0 = EPI_COL(u, bj);
            EPI_FOR_AM { int r = EPI_ROW(u, ai, m); EPI_PIN(r);
                *(u32x4*)(MG + (size_t)r * 1024 + c0) = pack8(acc[ai][bj][m][0], acc[ai][bj][m][1]);
                __builtin_amdgcn_sched_barrier(0); } }
    }
};
struct EpiMergeB {
    static constexpr bool MID = false;
    bf16_t* MG; const bf16_t* P;
    __device__ __forceinline__ void operator()(Acc& acc, const Unit& u, int wr, int wc, int fr, int fq) const {
        EPI_FOR_BJ { const int c0 = EPI_COL(u, bj);
            EPI_FOR_AM { int r = EPI_ROW(u, ai, m); EPI_PIN(r);
                const u32x4 gb = *(const u32x4*)(P + (size_t)r * INWP + OFF_GB + c0);
                const u32x4 mo = *(const u32x4*)(MG + (size_t)r * 1024 + c0);
#pragma unroll
                for (int e = 0; e < 8; ++e) {
                    const float g = sigmoidf_((e & 1) ? bf_hi(gb[e >> 1]) : bf_lo(gb[e >> 1])), o = (e & 1) ? bf_hi(mo[e >> 1]) : bf_lo(mo[e >> 1]);
                    acc[ai][bj][m][e >> 2][e & 3] = o + acc[ai][bj][m][e >> 2][e & 3] * g;
                }
                __builtin_amdgcn_sched_barrier(0); } }
        EPI_FOR_BJ { const int c0 = EPI_COL(u, bj);
            EPI_FOR_AM { int r = EPI_ROW(u, ai, m); EPI_PIN(r);
                *(u32x4*)(MG + (size_t)r * 1024 + c0) = pack8(acc[ai][bj][m][0], acc[ai][bj][m][1]);
                __builtin_amdgcn_sched_barrier(0); } }
    }
};

struct EpiOut {
    static constexpr bool MID = false;
    float* RES; const float* x_in; const float* ctx_in; const float* mod; int layer;
    __device__ __forceinline__ void operator()(Acc& acc, const Unit& u, int wr, int wc, int fr, int fq) const {
        const int b = u.pm / 33; const bool is_ctx = (u.pm % 33) == 0;
        const float* g1 = mod + (size_t)(is_ctx ? 4 : b) * 6144 + 2048;
        f32x4 g0[2], g4[2];
        EPI_FOR_BJ { const int c0 = EPI_COL(u, bj); g0[bj] = *(const f32x4*)(g1 + c0); g4[bj] = *(const f32x4*)(g1 + c0 + 4); }
        EPI_FOR_BJ { const int c0 = EPI_COL(u, bj);
            EPI_FOR_AM { int r = EPI_ROW(u, ai, m); EPI_PIN(r);
                const float* xr;
                if (layer == 0) { const int j = r % RPB; xr = is_ctx ? ctx_in + ((size_t)(b * CTXL + j)) * 1024 : x_in + ((size_t)(b * SEQ + j - CTXL)) * 1024; }
                else xr = RES + (size_t)r * 1024;
                const f32x4 x0 = *(const f32x4*)(xr + c0), x4 = *(const f32x4*)(xr + c0 + 4);
                acc[ai][bj][m][0] = x0 * DN_ALPHA + g0[bj] * acc[ai][bj][m][0];
                acc[ai][bj][m][1] = x4 * DN_ALPHA + g4[bj] * acc[ai][bj][m][1];
                __builtin_amdgcn_sched_barrier(0); }
            EPI_FOR_AM { int r = EPI_ROW(u, ai, m); EPI_PIN(r);
                *(f32x4*)(RES + (size_t)r * 1024 + c0) = acc[ai][bj][m][0];
                *(f32x4*)(RES + (size_t)r * 1024 + c0 + 4) = acc[ai][bj][m][1];
                __builtin_amdgcn_sched_barrier(0); } }
    }
};

struct EpiGU {
    static constexpr bool MID = false;
    bf16_t* ACT; const float* bgu;
    __device__ __forceinline__ void operator()(Acc& acc, const Unit& u, int wr, int wc, int fr, int fq) const {
        const int cj = u.pn * 128 + wc * 32 + 8 * fq;
        const float* bb = bgu + (size_t)u.e * 2048;
        const f32x4 bg0 = *(const f32x4*)(bb + cj), bg1 = *(const f32x4*)(bb + cj + 4), bu0 = *(const f32x4*)(bb + 1024 + cj), bu1 = *(const f32x4*)(bb + 1024 + cj + 4);
        EPI_FOR_AM { int r = EPI_ROW(u, ai, m); EPI_PIN(r);
            float v[8];
#pragma unroll
            for (int e = 0; e < 8; ++e) {
                const float gb = (e < 4) ? bg0[e & 3] : bg1[e & 3], ub = (e < 4) ? bu0[e & 3] : bu1[e & 3];
                const float gate = fminf(acc[ai][0][m][e >> 2][e & 3] + gb, SW_LIMIT);
                const float up = fminf(fmaxf(acc[ai][1][m][e >> 2][e & 3] + ub, -SW_LIMIT), SW_LIMIT);
                v[e] = (up + 1.0f) * gate * sigmoidf_(SW_ALPHA * gate);
            }
            u32x4 o = {pk_bf16(v[0], v[1]), pk_bf16(v[2], v[3]), pk_bf16(v[4], v[5]), pk_bf16(v[6], v[7])};
            *(u32x4*)(ACT + (size_t)r * 1024 + cj) = o;
            __builtin_amdgcn_sched_barrier(0); }
    }
};

struct EpiDown {
    static constexpr bool MID = false;
    bf16_t* YS; const float* bdn; const float* gws;
    __device__ __forceinline__ void operator()(Acc& acc, const Unit& u, int wr, int wc, int fr, int fq) const {
        const float* bb = bdn + (size_t)u.e * 1024;
        float g[2][4]; f32x4 b0[2], b1[2];
        EPI_FOR_AM { const int r = EPI_ROW(u, ai, m); g[ai][m] = gws[r]; }
        EPI_FOR_BJ { const int c0 = EPI_COL(u, bj); b0[bj] = *(const f32x4*)(bb + c0); b1[bj] = *(const f32x4*)(bb + c0 + 4); }
        EPI_FOR_BJ { const int c0 = EPI_COL(u, bj);
            EPI_FOR_AM { int r = EPI_ROW(u, ai, m); EPI_PIN(r);
                *(u32x4*)(YS + (size_t)r * 1024 + c0) = pack8((acc[ai][bj][m][0] + b0[bj]) * g[ai][m], (acc[ai][bj][m][1] + b1[bj]) * g[ai][m]);
                __builtin_amdgcn_sched_barrier(0); } }
    }
};

struct ConvJob { const float* src; int ldsrc, k0, n0, Kvalid, Nvalid; const float* kscale; bf16_t* dst; int lddst; };

__device__ __forceinline__ void conv_tile4(const ConvJob (&J)[4], float* T  , const int tid) {
    f32x4 v[8];
    const int n4 = (tid & 63) * 4, jt = n4 >> 6, nn0 = n4 & 63;
    const float* const src0 = J[0].src; const int ld0 = J[0].ldsrc, kb0 = J[0].k0 + (tid >> 6), nb0 = J[0].n0 + n4, kv0 = J[0].Kvalid;
    const bool nok = nb0 < J[0].Nvalid;
#pragma unroll
    for (int it = 0; it < 8; ++it) {
        f32x4 t = {0.f, 0.f, 0.f, 0.f};
        if (nok && kb0 + 8 * it < kv0) t = *(const f32x4*)(src0 + (size_t)(kb0 + 8 * it) * ld0 + nb0);
        v[it] = t;
    }
    if (J[0].kscale) {
        const float* const ks = J[0].kscale;
#pragma unroll
        for (int it = 0; it < 8; ++it) { float sc = 1.0f; if (kb0 + 8 * it < kv0) sc = ks[kb0 + 8 * it]; v[it] *= sc; }
    }
    float* const tp0 = T + jt * 4160 + (tid >> 6) * 65 + nn0;
#pragma unroll
    for (int it = 0; it < 8; ++it) { float* tp = tp0 + it * 8 * 65; tp[0] = v[it][0]; tp[1] = v[it][1]; tp[2] = v[it][2]; tp[3] = v[it][3]; }
    __syncthreads();
#pragma unroll
    for (int j = 0; j < 4; ++j) {
        const int nn = tid >> 3, k8 = (tid & 7) * 8;
        const float* tp = T + j * 4160 + k8 * 65 + nn;
        u32x4 o = {pk_bf16(tp[0], tp[65]), pk_bf16(tp[130], tp[195]), pk_bf16(tp[260], tp[325]), pk_bf16(tp[390], tp[455])};
        *(u32x4*)(J[j].dst + (size_t)nn * J[j].lddst + k8) = o;
    }
    __syncthreads();
}

constexpr int CONV_PER_LAYER = 1024 + 48 + 64 + 256 + 256 + 16384 + 8192;

__device__ __forceinline__ void conv_decode(const Args& a, int job, ConvJob& J) {
    const int l = job / CONV_PER_LAYER; int r = job % CONV_PER_LAYER;
    unsigned char* ws = a.ws;
    J.kscale = nullptr; J.Kvalid = 1 << 30; J.Nvalid = 1 << 30;
    if (r < 1024) {
        const int kt = r >> 6, ntl = r & 63;
        J.src = a.in[6] + (size_t)l * 1024 * INW; J.ldsrc = INW; J.k0 = kt * 64; J.n0 = ntl * 64; J.Nvalid = INW;
        J.dst = (bf16_t*)(ws + WS_WTIN) + (size_t)l * INWP * 1024 + (size_t)(ntl * 64) * 1024 + kt * 64; J.lddst = 1024; return;
    }
    r -= 1024;
    if (r < 48) {
        const int kt = r / 12, ntl = r % 12;
        J.src = a.in[10] + (size_t)l * 256 * 768; J.ldsrc = 768; J.k0 = kt * 64; J.n0 = ntl * 64; J.kscale = a.in[8] + l * 256;
        J.dst = (bf16_t*)(ws + WS_WTUQ) + (size_t)l * 768 * 256 + (size_t)(ntl * 64) * 256 + kt * 64; J.lddst = 256; return;
    }
    r -= 48;
    if (r < 64) {
        const int kt = r >> 4, ntl = r & 15;
        J.src = (ntl < 8 ? a.in[11] : a.in[12]) + (size_t)l * 128 * 512; J.ldsrc = 512; J.k0 = kt * 64; J.n0 = (ntl & 7) * 64; J.Kvalid = 128; J.kscale = a.in[9] + l * 128;
        J.dst = (bf16_t*)(ws + WS_WTUKV) + (size_t)l * 1024 * 256 + (size_t)(ntl * 64) * 256 + kt * 64; J.lddst = 256; return;
    }
    r -= 64;
    if (r < 256) {
        const int kt = r >> 4, ntl = r & 15;
        J.src = (kt < 8 ? a.in[13] : a.in[16]) + (size_t)l * 512 * 1024; J.ldsrc = 1024; J.k0 = (kt & 7) * 64; J.n0 = ntl * 64;
        J.dst = (bf16_t*)(ws + WS_WTOAB) + (size_t)l * 1024 * 1024 + (size_t)(kt >> 3) * 1024 * 512 + (size_t)(ntl * 64) * 512 + (kt & 7) * 64; J.lddst = 512; return;
    }
    r -= 256;
    if (r < 256) {
        const int kt = r >> 4, ntl = r & 15;
        J.src = a.in[17] + (size_t)l * 1024 * 1024; J.ldsrc = 1024; J.k0 = kt * 64; J.n0 = ntl * 64;
        J.dst = (bf16_t*)(ws + WS_WTO) + (size_t)l * 1024 * 1024 + (size_t)(ntl * 64) * 1024 + kt * 64; J.lddst = 1024; return;
    }
    r -= 256;
    if (r < 16384) {
        const int e = r >> 9, rr = r & 511, kt = rr >> 5, ntl = rr & 31, n0 = ntl * 64;
        J.src = a.in[24] + ((size_t)(l * NEXP + e)) * 1024 * 2048; J.ldsrc = 2048; J.k0 = kt * 64; J.n0 = n0;
        const int jj = n0 & 1023, row0 = (jj >> 7) * 256 + (n0 >= 1024 ? 128 : 0) + (jj & 127);
        J.dst = (bf16_t*)(ws + WS_WTGU) + ((size_t)(l * NEXP + e)) * 2048 * 1024 + (size_t)row0 * 1024 + kt * 64; J.lddst = 1024; return;
    }
    r -= 16384;
    {
        const int e = r >> 8, rr = r & 255, kt = rr >> 4, ntl = rr & 15;
        J.src = a.in[26] + ((size_t)(l * NEXP + e)) * 1024 * 1024; J.ldsrc = 1024; J.k0 = kt * 64; J.n0 = ntl * 64;
        J.dst = (bf16_t*)(ws + WS_WTDN) + ((size_t)(l * NEXP + e)) * 1024 * 1024 + (size_t)(ntl * 64) * 1024 + kt * 64; J.lddst = 1024;
    }
}

__device__ __forceinline__ void p0_phase(const Args& a, unsigned char* ldsg, const int wid_s) {
    const int tid = mk_tid(wid_s), G = gridDim.x, bid = blockIdx.x;
    float* LF = (float*)ldsg;
    if (bid == 0) { ((int*)(a.ws + WS_CTL))[tid] = 0; ((int*)(a.ws + WS_CTL))[tid + 512] = 0; }
    for (int idx = bid * NTHREADS + tid; idx < SEQ * 16; idx += G * NTHREADS) {
        const int t = idx >> 4, i = idx & 15;
        const float pos = (float)((i < 8) ? (t >> 6) : (t & 63));
        const float fr_ = powf(10000.0f, -(float)(2 * (i & 7)) / 16.0f);
        const float ang = pos * fr_;
        const double turns = (double)ang * 0.15915494309189535;
        const float frac = (float)(turns - rint(turns));
        ((float2*)(a.ws + WS_ROPE))[idx] = make_float2(__builtin_amdgcn_cosf(frac), __builtin_amdgcn_sinf(frac));
    }
    for (int job = bid; job < DEPTH * 96; job += G) {
        const int l = job / 96, g = job % 96;
        for (int i = tid; i < 5 * 1024; i += NTHREADS) {
            const int m = i >> 10, k = i & 1023;
            const float c = (m < 4) ? a.in[1][m * 1024 + k] : a.in[3][k];
            LF[i] = c / (1.0f + __expf(-c));
        }
        __syncthreads();
        const int col = g * 64 + (tid & 63), kq = tid >> 6;
        const float* w = a.in[4] + (size_t)l * 1024 * 6144 + col;
        float s0 = 0.f, s1 = 0.f, s2 = 0.f, s3 = 0.f, s4 = 0.f;
#pragma unroll 32
        for (int k = kq * 128; k < kq * 128 + 128; ++k) {
            const float wv = w[(size_t)k * 6144];
            s0 += LF[k] * wv; s1 += LF[1024 + k] * wv; s2 += LF[2048 + k] * wv; s3 += LF[3072 + k] * wv; s4 += LF[4096 + k] * wv;
        }
        float* red = LF + 5120;
        red[(kq * 5 + 0) * 64 + (tid & 63)] = s0; red[(kq * 5 + 1) * 64 + (tid & 63)] = s1; red[(kq * 5 + 2) * 64 + (tid & 63)] = s2;
        red[(kq * 5 + 3) * 64 + (tid & 63)] = s3; red[(kq * 5 + 4) * 64 + (tid & 63)] = s4;
        __syncthreads();
        if (tid < 320) {
            const int m = tid >> 6, cc = tid & 63; float s = 0.f;
#pragma unroll
            for (int q = 0; q < 8; ++q) s += red[(q * 5 + m) * 64 + cc];
            ((float*)(a.ws + WS_MOD))[((size_t)(l * 5 + m)) * 6144 + g * 64 + cc] = s + a.in[5][l * 6144 + g * 64 + cc];
        }
        __syncthreads();
    }
    for (int job = bid * 4; job < DEPTH * CONV_PER_LAYER; job += G * 4) { ConvJob J[4]; conv_decode(a, job, J[0]); conv_decode(a, job + 1, J[1]); conv_decode(a, job + 2, J[2]); conv_decode(a, job + 3, J[3]); conv_tile4(J, LF, tid); }
}

__device__ __forceinline__ void p1_phase(const Args& a, const int wid_s) {
    const int tid_ = mk_tid(wid_s);
    const int lane = tid_ & 63, gw = blockIdx.x * 8 + (tid_ >> 6), nw = gridDim.x * 8;
    const float* mod = (const float*)(a.ws + WS_MOD);
    bf16_t* HB = (bf16_t*)(a.ws + WS_HB);
    f32x4 xn[4];
    const float* const x_in = a.in[0]; const float* const c_in = a.in[2];
#define P1_LOAD(Rq) do { const int Rc_ = min((Rq), MR - 1); const int b_ = Rc_ / RPB, j_ = Rc_ % RPB; \
        const float* src_ = (j_ < CTXL) ? c_in + ((size_t)(b_ * CTXL + j_)) * 1024 : x_in + ((size_t)(b_ * SEQ + j_ - CTXL)) * 1024; \
        _Pragma("unroll") for (int i = 0; i < 4; ++i) xn[i] = *(const f32x4*)(src_ + (lane + 64 * i) * 4); } while (0)
    P1_LOAD(gw);
    for (int R = gw; R < MR; R += nw) {
        const int b = R / RPB, j = R % RPB;
        const float* md = mod + (size_t)((j < CTXL) ? 4 : b) * 6144;
        f32x4 xc[4];
#pragma unroll
        for (int i = 0; i < 4; ++i) xc[i] = xn[i];
        P1_LOAD(R + nw);
#pragma unroll
        for (int i = 0; i < 4; ++i) {
            const int k = (lane + 64 * i) * 4;
            const f32x4 sh = *(const f32x4*)(md + k), sc = *(const f32x4*)(md + 1024 + k);
            const f32x4 h = xc[i] * (sc + 1.0f) + sh;
            u32x2 o = {pk_bf16(h[0], h[1]), pk_bf16(h[2], h[3])};
            *(u32x2*)(HB + (size_t)R * 1024 + k) = o;
        }
    }
#undef P1_LOAD
}

__device__ __forceinline__ void rowa_phase(const Args& a, int l, const int wid_s) {
    const int tid_ = mk_tid(wid_s);
    const int lane = tid_ & 63, gw = blockIdx.x * 8 + (tid_ >> 6), nw = gridDim.x * 8;
    const bf16_t* P = (const bf16_t*)(a.ws + WS_P);
    float* rsq = (float*)(a.ws + WS_RSQ); float* rskv = (float*)(a.ws + WS_RSKV);
    bf16_t* KR = (bf16_t*)(a.ws + WS_KR); bf16_t* AC = (bf16_t*)(a.ws + WS_AC);
    const float2* cs = (const float2*)(a.ws + WS_ROPE);
    const float* cw = a.in[14] + (size_t)l * 3 * 512; const float* cb = a.in[15] + (size_t)l * 512;
    const int c8 = lane * 8;
    float w0[8], w1[8], w2[8], bs[8];
#pragma unroll
    for (int e = 0; e < 8; ++e) { w0[e] = cw[c8 + e]; w1[e] = cw[512 + c8 + e]; w2[e] = cw[1024 + c8 + e]; bs[e] = cb[c8 + e]; }
    u32x2 nqa; unsigned nka; bf16_t nkr; u32x4 nuc, nbc, ncc, nup, ncp, nun, ncn;
#define RA_LOAD(Rq) do { const int Rc_ = min((Rq), MR - 1); const bf16_t* pr_ = P + (size_t)Rc_ * INWP; const int j_ = Rc_ % RPB; \
        const bool hp_ = (j_ != 0) && (j_ != CTXL), hn_ = (j_ != CTXL - 1) && (j_ != RPB - 1); const u32x4 z_ = {0u, 0u, 0u, 0u}; \
        nqa = *(const u32x2*)(pr_ + lane * 4); nka = *(const unsigned*)(pr_ + OFF_KV + lane * 2); nkr = pr_[OFF_KR + (lane & 31)]; \
        nuc = *(const u32x4*)(pr_ + OFF_CX + c8); nbc = *(const u32x4*)(pr_ + OFF_CB + c8); ncc = *(const u32x4*)(pr_ + OFF_CC + c8); \
        nup = hp_ ? *(const u32x4*)(pr_ - INWP + OFF_CX + c8) : z_; ncp = hp_ ? *(const u32x4*)(pr_ - INWP + OFF_CC + c8) : z_; \
        nun = hn_ ? *(const u32x4*)(pr_ + INWP + OFF_CX + c8) : z_; ncn = hn_ ? *(const u32x4*)(pr_ + INWP + OFF_CC + c8) : z_; } while (0)
    RA_LOAD(gw);
    for (int R = gw; R < MR; R += nw) {
        const int j = R % RPB;
        const u32x2 qa = nqa; const unsigned ka = nka; const bf16_t krv = nkr;
        const u32x4 uc = nuc, bc = nbc, cc = ncc, up = nup, cp = ncp, un = nun, cn = ncn;
        RA_LOAD(R + nw);
        float sq = bf_lo(qa[0]) * bf_lo(qa[0]) + bf_hi(qa[0]) * bf_hi(qa[0]) + bf_lo(qa[1]) * bf_lo(qa[1]) + bf_hi(qa[1]) * bf_hi(qa[1]);
        float sk = bf_lo(ka) * bf_lo(ka) + bf_hi(ka) * bf_hi(ka);
        sq = wave_sum(sq, lane); sk = wave_sum(sk, lane);
        if (lane == 0) { rsq[R] = rsqrtf(sq * (1.0f / 256.0f) + NORM_EPS); rskv[R] = rsqrtf(sk * (1.0f / 128.0f) + NORM_EPS); }
        {
            const float v = bf2f(krv);
            const float pv = swz<8>(v);
            float o = v;
            if (j >= CTXL) { const int i = lane & 31; const float2 c2 = cs[(size_t)(j - CTXL) * 16 + (i >> 4) * 8 + (i & 7)]; o = v * c2.x + (((i >> 3) & 1) ? pv : -pv) * c2.y; }
            const float o2 = swz<1>(o);
            if (lane < 32 && !(lane & 1)) *(unsigned*)(KR + (size_t)R * 32 + lane) = pk_bf16(o, o2);
        }
        float y[8];
#pragma unroll
        for (int e = 0; e < 8; ++e) {
            const int q = e >> 1;
            const float zc = (e & 1) ? bf_hi(uc[q]) * bf_hi(cc[q]) : bf_lo(uc[q]) * bf_lo(cc[q]);
            const float zp = (e & 1) ? bf_hi(up[q]) * bf_hi(cp[q]) : bf_lo(up[q]) * bf_lo(cp[q]);
            const float zn = (e & 1) ? bf_hi(un[q]) * bf_hi(cn[q]) : bf_lo(un[q]) * bf_lo(cn[q]);
            const float bg = (e & 1) ? bf_hi(bc[q]) : bf_lo(bc[q]);
            y[e] = bg * (w0[e] * zp + w1[e] * zc + w2[e] * zn + bs[e]);
        }
        u32x4 o = {pk_bf16(y[0], y[1]), pk_bf16(y[2], y[3]), pk_bf16(y[4], y[5]), pk_bf16(y[6], y[7])};
        *(u32x4*)(AC + (size_t)R * 1024 + 512 + c8) = o;
    }
#undef RA_LOAD
}

__device__ __forceinline__ void router_tail(const f32x16 plo, const f32x16 phi, const int lane, const float* br_, const bool live, const int lrow, int* lcnt, int* rec_e, int* rec_p, float* rec_g) {
    const bool u5 = (lane & 32) != 0, u4 = (lane & 16) != 0, u3 = (lane & 8) != 0, u2 = (lane & 4) != 0, u1 = (lane & 2) != 0;
    f32x16 k16 = u5 ? phi : plo; const f32x16 s16 = u5 ? plo : phi;
#pragma unroll
    for (int i = 0; i < 16; ++i) k16[i] += shx32(s16[i], lane);
    f32x8 k8 = u4 ? k16.hi : k16.lo; const f32x8 s8 = u4 ? k16.lo : k16.hi;
#pragma unroll
    for (int i = 0; i < 8; ++i) k8[i] += swz<16>(s8[i]);
    f32x4 k4 = u3 ? k8.hi : k8.lo; const f32x4 s4 = u3 ? k8.lo : k8.hi;
#pragma unroll
    for (int i = 0; i < 4; ++i) k4[i] += swz<8>(s4[i]);
    f32x2 k2 = u2 ? k4.hi : k4.lo; const f32x2 s2 = u2 ? k4.lo : k4.hi;
#pragma unroll
    for (int i = 0; i < 2; ++i) k2[i] += swz<4>(s2[i]);
    float k1 = u1 ? k2.y : k2.x; const float s1 = u1 ? k2.x : k2.y;
    k1 += swz<2>(s1);
    const int myE = lane >> 1;
    const float mylog = k1 + swz<1>(k1) + br_[myE];
    int rank = 0;
#pragma unroll
    for (int e = 0; e < 32; ++e) {
        const float le = __uint_as_float(__builtin_amdgcn_readlane(__float_as_uint(mylog), 2 * e));
        rank += ((le > mylog) || (le == mylog && e < myE)) ? 1 : 0;
    }
    const bool even = !(lane & 1);
    const unsigned long long m0 = __ballot(even && rank == 0), m1 = __ballot(even && rank == 1), m2 = __ballot(even && rank == 2), m3 = __ballot(even && rank == 3);
    const float v0 = __uint_as_float(__builtin_amdgcn_readlane(__float_as_uint(mylog), __builtin_ctzll(m0)));
    const float v1 = __uint_as_float(__builtin_amdgcn_readlane(__float_as_uint(mylog), __builtin_ctzll(m1)));
    const float v2 = __uint_as_float(__builtin_amdgcn_readlane(__float_as_uint(mylog), __builtin_ctzll(m2)));
    const float v3 = __uint_as_float(__builtin_amdgcn_readlane(__float_as_uint(mylog), __builtin_ctzll(m3)));
    const float inv = 1.0f / (1.0f + __expf(v1 - v0) + __expf(v2 - v0) + __expf(v3 - v0));
    if (live && even && rank < 4) {
        const float g = __expf(mylog - v0) * inv;
        const int lp = atomicAdd(&lcnt[myE], 1);
        const int li = lrow * 4 + rank;
        rec_e[li] = myE; rec_p[li] = lp; rec_g[li] = g;
    }
}

__device__ __forceinline__ void ln1_router_phase(const Args& a, int l, unsigned char* ldsg, const int wid_s) {
    const int tid_ = mk_tid(wid_s);
    const int tid = tid_, lane = tid & 63, wid = tid >> 6, G = gridDim.x, bid = blockIdx.x;
    float* WT = (float*)ldsg;
    int* lcnt = (int*)(ldsg + MISC_OFF);
    int* lbase = lcnt + 32;
    int* rec_e = lbase + 32;
    int* rec_p = rec_e + 1024;
    float* rec_g = (float*)(rec_p + 1024);
    const float* wr_ = a.in[22] + (size_t)l * 1024 * 32; const float* br_ = a.in[23] + l * 32;
    {
        f32x4 wv[16];
#pragma unroll
        for (int j = 0; j < 16; ++j) wv[j] = *(const f32x4*)(wr_ + (size_t)(tid + NTHREADS * j) * 4);
#pragma unroll
        for (int j = 0; j < 16; ++j) { const int idx = (tid + NTHREADS * j) * 4, k = idx >> 5, e = idx & 31;
#pragma unroll
            for (int c = 0; c < 4; ++c) WT[(e + c) * 1024 + k] = wv[j][c]; }
    }
    if (tid < 32) lcnt[tid] = 0;
    __syncthreads();
    const int rpb = (MR + G - 1) / G, r0 = bid * rpb, r1 = min(MR, r0 + rpb);
    float* RES = (float*)(a.ws + WS_RES); bf16_t* HB = (bf16_t*)(a.ws + WS_HB);
    const float* mod = (const float*)(a.ws + WS_MOD) + (size_t)l * 5 * 6144;
    const float* lg_ = a.in[18] + l * 1024; const float* lb_ = a.in[19] + l * 1024;
    const bool lastl = (l == DEPTH - 1);
    f32x4 na[4], nb[4];
#define L1_LOAD(Rq) do { const int Ra_ = min((Rq), MR - 1), Rb_ = min((Rq) + 8, MR - 1); _Pragma("unroll") for (int i = 0; i < 4; ++i) { \
        na[i] = *(const f32x4*)(RES + (size_t)Ra_ * 1024 + (lane + 64 * i) * 4); nb[i] = *(const f32x4*)(RES + (size_t)Rb_ * 1024 + (lane + 64 * i) * 4); } } while (0)
    L1_LOAD(r0 + wid);
    for (int Ra = r0 + wid; Ra < r1; Ra += 16) {
        const bool has2 = (Ra + 8 < r1);
        const int Rb = has2 ? Ra + 8 : Ra;
        f32x4 va[4], vb[4];
#pragma unroll
        for (int i = 0; i < 4; ++i) { va[i] = na[i]; vb[i] = has2 ? nb[i] : na[i]; }
        L1_LOAD(Ra + 16);
        const int ja = Ra % RPB, jb = Rb % RPB;
        const bool livea = !(lastl && ja < CTXL), liveb = has2 && !(lastl && jb < CTXL);
        if (!livea && !liveb) continue;
        const float* mda = mod + (size_t)((ja < CTXL) ? 4 : Ra / RPB) * 6144;
        const float* mdb = mod + (size_t)((jb < CTXL) ? 4 : Rb / RPB) * 6144;
        float sa_ = 0.f, sb_ = 0.f;
#pragma unroll
        for (int i = 0; i < 4; ++i) { sa_ += va[i][0] + va[i][1] + va[i][2] + va[i][3]; sb_ += vb[i][0] + vb[i][1] + vb[i][2] + vb[i][3]; }
        const float mua = wave_sum(sa_, lane) * (1.0f / 1024.0f), mub = wave_sum(sb_, lane) * (1.0f / 1024.0f);
        float qa = 0.f, qb = 0.f;
#pragma unroll
        for (int i = 0; i < 4; ++i) { va[i] = va[i] - mua; vb[i] = vb[i] - mub; qa += va[i][0] * va[i][0] + va[i][1] * va[i][1] + va[i][2] * va[i][2] + va[i][3] * va[i][3]; qb += vb[i][0] * vb[i][0] + vb[i][1] * vb[i][1] + vb[i][2] * vb[i][2] + vb[i][3] * vb[i][3]; }
        const float rsa = rsqrtf(wave_sum(qa, lane) * (1.0f / 1024.0f) + NORM_EPS), rsb = rsqrtf(wave_sum(qb, lane) * (1.0f / 1024.0f) + NORM_EPS);
        f32x2 hp[4][4];
#pragma unroll
        for (int i = 0; i < 4; ++i) {
            const int k = (lane + 64 * i) * 4;
            const f32x4 gg = *(const f32x4*)(lg_ + k), bb = *(const f32x4*)(lb_ + k);
            const f32x4 xa = va[i] * rsa * gg + bb, xb = vb[i] * rsb * gg + bb;
            const f32x4 ha = xa * (*(const f32x4*)(mda + 4096 + k) + 1.0f) + *(const f32x4*)(mda + 3072 + k);
            const f32x4 hb = xb * (*(const f32x4*)(mdb + 4096 + k) + 1.0f) + *(const f32x4*)(mdb + 3072 + k);
#pragma unroll
            for (int c = 0; c < 4; ++c) hp[i][c] = (f32x2){ha[c], hb[c]};
            if (livea) { *(f32x4*)(RES + (size_t)Ra * 1024 + k) = xa; u32x2 o = {pk_bf16(ha[0], ha[1]), pk_bf16(ha[2], ha[3])}; *(u32x2*)(HB + (size_t)Ra * 1024 + k) = o; }
            if (liveb) { *(f32x4*)(RES + (size_t)Rb * 1024 + k) = xb; u32x2 o = {pk_bf16(hb[0], hb[1]), pk_bf16(hb[2], hb[3])}; *(u32x2*)(HB + (size_t)Rb * 1024 + k) = o; }
        }
        f32x2 pl2[32];
#pragma unroll
        for (int e = 0; e < 32; ++e) {
            f32x2 acc2 = {0.f, 0.f};
#pragma unroll
            for (int i = 0; i < 4; ++i) {
                const f32x4 w = *(const f32x4*)(WT + e * 1024 + (lane + 64 * i) * 4);
#pragma unroll
                for (int c = 0; c < 4; ++c) acc2 = __builtin_elementwise_fma(hp[i][c], (f32x2){w[c], w[c]}, acc2);
            }
            pl2[e] = acc2;
            if ((e & 3) == 3) __builtin_amdgcn_sched_barrier(0);
        }
        {
            const f32x16 plo = {pl2[0].x, pl2[1].x, pl2[2].x, pl2[3].x, pl2[4].x, pl2[5].x, pl2[6].x, pl2[7].x, pl2[8].x, pl2[9].x, pl2[10].x, pl2[11].x, pl2[12].x, pl2[13].x, pl2[14].x, pl2[15].x};
            const f32x16 phi = {pl2[16].x, pl2[17].x, pl2[18].x, pl2[19].x, pl2[20].x, pl2[21].x, pl2[22].x, pl2[23].x, pl2[24].x, pl2[25].x, pl2[26].x, pl2[27].x, pl2[28].x, pl2[29].x, pl2[30].x, pl2[31].x};
            router_tail(plo, phi, lane, br_, livea, Ra - r0, lcnt, rec_e, rec_p, rec_g);
        }
        {
            const f32x16 plo = {pl2[0].y, pl2[1].y, pl2[2].y, pl2[3].y, pl2[4].y, pl2[5].y, pl2[6].y, pl2[7].y, pl2[8].y, pl2[9].y, pl2[10].y, pl2[11].y, pl2[12].y, pl2[13].y, pl2[14].y, pl2[15].y};
            const f32x16 phi = {pl2[16].y, pl2[17].y, pl2[18].y, pl2[19].y, pl2[20].y, pl2[21].y, pl2[22].y, pl2[23].y, pl2[24].y, pl2[25].y, pl2[26].y, pl2[27].y, pl2[28].y, pl2[29].y, pl2[30].y, pl2[31].y};
            router_tail(plo, phi, lane, br_, liveb, Rb - r0, lcnt, rec_e, rec_p, rec_g);
        }
    }
#undef L1_LOAD
    __syncthreads();
    if (tid < 32) lbase[tid] = atomicAdd((int*)(a.ws + WS_CTL) + l * 32 + tid, lcnt[tid]);
    __syncthreads();
    int* RE = (int*)(a.ws + WS_RE); int* RP = (int*)(a.ws + WS_RPOS); float* RG = (float*)(a.ws + WS_RG);
    for (int i = tid; i < (r1 - r0) * 4; i += NTHREADS) {
        if (lastl && ((r0 + (i >> 2)) % RPB) < CTXL) continue;
        const int e = rec_e[i];
        RE[(size_t)r0 * 4 + i] = e; RP[(size_t)r0 * 4 + i] = lbase[e] + rec_p[i]; RG[(size_t)r0 * 4 + i] = rec_g[i];
    }
    __syncthreads();
}

__device__ __forceinline__ void moe_prefix(const Args& a, int l, unsigned char* ldsg, const int wid_s) {
    int* ts = (int*)(ldsg + MISC_OFF);
    __syncthreads();
    if (wid_s == 0 && lane_id() == 0) {
        const int* cnt = (const int*)(a.ws + WS_CTL) + l * 32; int acc_ = 0;
#pragma unroll 1
        for (int e = 0; e < 32; ++e) { ts[e] = acc_; ts[40 + e] = __hip_atomic_load(cnt + e, __ATOMIC_RELAXED, __HIP_MEMORY_SCOPE_AGENT); acc_ += (__hip_atomic_load(cnt + e, __ATOMIC_RELAXED, __HIP_MEMORY_SCOPE_AGENT) + 255) >> 8; }
        ts[32] = acc_;
    }
    __syncthreads();
}

__device__ __forceinline__ void gather_phase(const Args& a, int l, unsigned char* ldsg, const int wid_s) {
    moe_prefix(a, l, ldsg, wid_s);
    const int* ts = (const int*)(ldsg + MISC_OFF);
    const int tid = mk_tid(wid_s);
    const int* RE = (const int*)(a.ws + WS_RE); const int* RP = (const int*)(a.ws + WS_RPOS); const float* RG = (const float*)(a.ws + WS_RG);
    int* SO = (int*)(a.ws + WS_SLOTOF); float* GWS = (float*)(a.ws + WS_GWS); int* RO = (int*)(a.ws + WS_ROWOFF);
    const int G = gridDim.x;
    for (int i = blockIdx.x * NTHREADS + tid; i < MR * 4; i += G * NTHREADS) {
        const int R = i >> 2;
        if (l == DEPTH - 1 && (R % RPB) < CTXL) continue;
        const int slot = ts[RE[i] & 31] * 256 + RP[i];
        SO[i] = slot; GWS[slot] = RG[i]; RO[slot] = R * 2048;
    }
    for (int e = blockIdx.x; e < NEXP; e += G) {
        const int beg = ts[e] * 256 + ts[40 + e], end = ts[e + 1] * 256;
        for (int sl = beg + tid; sl < end; sl += NTHREADS) { RO[sl] = 0; GWS[sl] = 0.f; }
    }
}

__device__ __forceinline__ void ln2_phase(const Args& a, int l, const int wid_s) {
    const int tid_ = mk_tid(wid_s);
    const int lane = tid_ & 63, gw = blockIdx.x * 8 + (tid_ >> 6), nw = gridDim.x * 8;
    float* RES = (float*)(a.ws + WS_RES); bf16_t* HB = (bf16_t*)(a.ws + WS_HB); const bf16_t* YS = (const bf16_t*)(a.ws + WS_AS);
    const int* SO = (const int*)(a.ws + WS_SLOTOF);
    const float* mod = (const float*)(a.ws + WS_MOD) + (size_t)l * 5 * 6144;
    const float* modn = (const float*)(a.ws + WS_MOD) + (size_t)((l + 1) % DEPTH) * 5 * 6144;
    const float* lg_ = a.in[20] + l * 1024; const float* lb_ = a.in[21] + l * 1024;
    const bool last = (l == DEPTH - 1);
    int sl1[4], sl2[4];
    u32x2 ysn[4][4]; f32x4 rsn[4];
#define LN2_SLOTS(dst, Rq) do { const int Rc_ = min((Rq), MR - 1); _Pragma("unroll") for (int k = 0; k < 4; ++k) dst[k] = SO[Rc_ * 4 + k]; } while (0)
#define LN2_ROWS(Rq, slq) do { const int Rc_ = min((Rq), MR - 1); const bool skip_ = last && (Rc_ % RPB) < CTXL; _Pragma("unroll") for (int i = 0; i < 4; ++i) { const int k0_ = (lane + 64 * i) * 4; \
        rsn[i] = *(const f32x4*)(RES + (size_t)Rc_ * 1024 + k0_); _Pragma("unroll") for (int k = 0; k < 4; ++k) ysn[i][k] = *(const u32x2*)(YS + (size_t)(skip_ ? 0 : slq[k]) * 1024 + k0_); } } while (0)
    LN2_SLOTS(sl1, gw); LN2_SLOTS(sl2, gw + nw);
    LN2_ROWS(gw, sl1);
#pragma unroll
    for (int k = 0; k < 4; ++k) sl1[k] = sl2[k];
    for (int R = gw; R < MR; R += nw) {
        u32x2 ys[4][4]; f32x4 v[4];
#pragma unroll
        for (int i = 0; i < 4; ++i) { v[i] = rsn[i];
#pragma unroll
            for (int k = 0; k < 4; ++k) ys[i][k] = ysn[i][k]; }
        LN2_SLOTS(sl2, R + 2 * nw);
        LN2_ROWS(R + nw, sl1);
#pragma unroll
        for (int k = 0; k < 4; ++k) sl1[k] = sl2[k];
        const int b = R / RPB, j = R % RPB; const int mi = (j < CTXL) ? 4 : b;
        if (last && j < CTXL) continue;
        const float* md = mod + (size_t)mi * 6144;
        float* rr = RES + (size_t)R * 1024;
        float s = 0.f;
#pragma unroll
        for (int i = 0; i < 4; ++i) {
            const int k0 = (lane + 64 * i) * 4;
            f32x4 f = {0.f, 0.f, 0.f, 0.f};
#pragma unroll
            for (int k = 0; k < 4; ++k) { const u32x2 y = ys[i][k]; f[0] += bf_lo(y[0]); f[1] += bf_hi(y[0]); f[2] += bf_lo(y[1]); f[3] += bf_hi(y[1]); }
            v[i] = v[i] * DN_ALPHA + *(const f32x4*)(md + 5120 + k0) * f;
            s += v[i][0] + v[i][1] + v[i][2] + v[i][3];
        }
        const float mu = wave_sum(s, lane) * (1.0f / 1024.0f);
        float q = 0.f;
#pragma unroll
        for (int i = 0; i < 4; ++i) { v[i] = v[i] - mu; q += v[i][0] * v[i][0] + v[i][1] * v[i][1] + v[i][2] * v[i][2] + v[i][3] * v[i][3]; }
        const float rstd = rsqrtf(wave_sum(q, lane) * (1.0f / 1024.0f) + NORM_EPS);
#pragma unroll
        for (int i = 0; i < 4; ++i) {
            const int k0 = (lane + 64 * i) * 4;
            const f32x4 x2 = v[i] * rstd * *(const f32x4*)(lg_ + k0) + *(const f32x4*)(lb_ + k0);
            if (last) { *(f32x4*)(a.out + ((size_t)(b * SEQ + j - CTXL)) * 1024 + k0) = x2; }
            else {
                *(f32x4*)(rr + k0) = x2;
                const float* mn = modn + (size_t)mi * 6144;
                const f32x4 h = x2 * (*(const f32x4*)(mn + 1024 + k0) + 1.0f) + *(const f32x4*)(mn + k0);
                u32x2 o = {pk_bf16(h[0], h[1]), pk_bf16(h[2], h[3])};
                *(u32x2*)(HB + (size_t)R * 1024 + k0) = o;
            }
        }
    }
#undef LN2_SLOTS
#undef LN2_ROWS
}

constexpr int KROW = 208, VROW = 136, KBUF = 64 * KROW, VBUF = 64 * VROW, KVBUF = KBUF + VBUF;

template <int MODE> __device__ __forceinline__ f32x16 att_mma(const bf16x8 a_, const bf16x8 b_, f32x16 c_) {
    if (MODE == 2) { c_[0] += __builtin_bit_cast(f32x4, a_)[0] + __builtin_bit_cast(f32x4, b_)[1]; return c_; }
    return __builtin_amdgcn_mfma_f32_32x32x16_bf16(a_, b_, c_, 0, 0, 0);
}
#define ATT_MMA(a_, b_, c_, x_, y_, z_) att_mma<MODE>(a_, b_, c_)
template <int MODE>
__device__ __forceinline__ void attn_qk(const LAS unsigned char* kb_, const bf16x8 (&qf)[6], f32x16 (&st)[2], const int ql, const int hf) {
#define ATT_KF(kb, s) (*(const LAS bf16x8*)(kb_ + ((kb) * 32 + ql) * KROW + (s) * 32 + hf * 16))
    bf16x8 ka[4], kc[4], ke[4];
#pragma unroll
    for (int s = 0; s < 2; ++s) { ka[2 * s] = ATT_KF(0, s); ka[2 * s + 1] = ATT_KF(1, s); }
#pragma unroll
    for (int s = 2; s < 4; ++s) { kc[2 * (s - 2)] = ATT_KF(0, s); kc[2 * (s - 2) + 1] = ATT_KF(1, s); }
    __builtin_amdgcn_sched_barrier(0);
#pragma unroll
    for (int i = 0; i < 16; ++i) { st[0][i] = 0.f; st[1][i] = 0.f; }
#pragma unroll
    for (int s = 0; s < 2; ++s) { st[0] = ATT_MMA(ka[2 * s], qf[s], st[0], 0, 0, 0); st[1] = ATT_MMA(ka[2 * s + 1], qf[s], st[1], 0, 0, 0); }
    __builtin_amdgcn_sched_barrier(0);
#pragma unroll
    for (int s = 4; s < 6; ++s) { ke[2 * (s - 4)] = ATT_KF(0, s); ke[2 * (s - 4) + 1] = ATT_KF(1, s); }
    __builtin_amdgcn_sched_barrier(0);
#pragma unroll
    for (int s = 2; s < 4; ++s) { st[0] = ATT_MMA(kc[2 * (s - 2)], qf[s], st[0], 0, 0, 0); st[1] = ATT_MMA(kc[2 * (s - 2) + 1], qf[s], st[1], 0, 0, 0); }
#pragma unroll
    for (int s = 4; s < 6; ++s) { st[0] = ATT_MMA(ke[2 * (s - 4)], qf[s], st[0], 0, 0, 0); st[1] = ATT_MMA(ke[2 * (s - 4) + 1], qf[s], st[1], 0, 0, 0); }
#undef ATT_KF
}
template <int MODE>
__device__ __forceinline__ void attn_pv(const LAS unsigned char* vb_, f32x16 (&st)[2], f32x16 (&ot)[2], float& mrun, float& lsum, const int ql, const int hf, const int lane) {
    if (MODE != 1) {
    float mx = max3f(st[0][0], st[1][0], st[0][1]), my = max3f(st[1][1], st[0][2], st[1][2]);
#pragma unroll
    for (int i = 3; i < 15; i += 2) { mx = max3f(mx, st[0][i], st[1][i]); my = max3f(my, st[0][i + 1], st[1][i + 1]); }
    mx = max3f(mx, st[0][15], st[1][15]); mx = max3f(mx, my, my);
    if (__builtin_amdgcn_ballot_w64(mx > mrun + 8.0f) != 0ull) {
        mx = fmaxf(mx, shx32(mx, lane));
        const float mnew = (mx > mrun + 8.0f) ? mx : mrun;
        const float alpha = fexp2(mrun - mnew);
        mrun = mnew; lsum *= alpha;
#pragma unroll
        for (int i = 0; i < 16; ++i) { ot[0][i] *= alpha; ot[1][i] *= alpha; }
    }
    float ps = 0.f;
#pragma unroll
    for (int kb = 0; kb < 2; ++kb)
#pragma unroll
        for (int i = 0; i < 16; ++i) { const float p = fexp2(st[kb][i] - mrun); st[kb][i] = p; ps += p; }
    lsum += ps;
    } else lsum += st[0][0];
#pragma unroll
    for (int kb = 0; kb < 2; ++kb)
#pragma unroll
        for (int sI = 0; sI < 2; ++sI) {
            u32x4 pw = {pk_bf16(st[kb][8 * sI + 0], st[kb][8 * sI + 1]), pk_bf16(st[kb][8 * sI + 2], st[kb][8 * sI + 3]),
                        pk_bf16(st[kb][8 * sI + 4], st[kb][8 * sI + 5]), pk_bf16(st[kb][8 * sI + 6], st[kb][8 * sI + 7])};
            const bf16x8 pf = __builtin_bit_cast(bf16x8, pw);
#pragma unroll
            for (int db = 0; db < 2; ++db) {
                const LAS unsigned char* vp = vb_ + (db * 32 + ql) * VROW + (kb * 32 + 16 * sI + 4 * hf) * 2;
                const u32x2 v0 = *(const LAS u32x2*)vp, v1 = *(const LAS u32x2*)(vp + 16);
                u32x4 vw = {v0[0], v0[1], v1[0], v1[1]};
                ot[db] = att_mma<MODE>(__builtin_bit_cast(bf16x8, vw), pf, ot[db]);
            }
        }
}

template <int MODE>
__device__ __forceinline__ void attn_phase(const Args& a, bool do_ctx, LAS unsigned char* lds, const int wid_s) {
    const int tid = mk_tid(wid_s);
    const int lane = tid & 63, wid = wid_s, ql = lane & 31, hf = lane >> 5, G = gridDim.x;
    const bf16_t* Q = (const bf16_t*)(a.ws + WS_Q); const bf16_t* KN = (const bf16_t*)(a.ws + WS_KN); const bf16_t* KR = (const bf16_t*)(a.ws + WS_KR);
    const bf16_t* VT = (const bf16_t*)(a.ws + WS_VT); bf16_t* AC = (bf16_t*)(a.ws + WS_AC);
    const int nitems = 1024 + (do_ctx ? 32 : 0);
    LAS unsigned char* const ldsv = lds + 2 * KBUF;
    for (int it = 0;; ++it) {
        const long L = (long)it * G + blockIdx.x; if (L >= nitems) break;
        int b, h, qt, nkt;
        if (L < 1024) { const int x = (int)(L % 8), q = (int)((L / 8) % 32), bh = (int)(L / 256) * 8 + x; b = bh >> 3; h = bh & 7; qt = q + 1; nkt = RPB / 64; }
        else { const int bh = (int)(L - 1024); b = bh >> 3; h = bh & 7; qt = 0; nkt = CTXL / 64; }
        const int rowbase = b * RPB;
        const int qrow = rowbase + qt * 256 + wid * 32 + ql;
        bf16x8 qf[6];
#pragma unroll
        for (int s = 0; s < 6; ++s) qf[s] = *(const bf16x8*)(Q + (size_t)qrow * 768 + h * 96 + s * 16 + hf * 8);
        const bf16_t* gkn = KN + ((size_t)(rowbase + (tid >> 3))) * 512 + h * 64 + (tid & 7) * 8;
        const bf16_t* gkr = KR + ((size_t)(rowbase + ((tid & 255) >> 2))) * 32 + (tid & 3) * 8;
        const bf16_t* gvt = VT + ((size_t)((b * NH + h) * 64 + (tid >> 3))) * RPB + (tid & 7) * 8;
        const unsigned skn = (unsigned)((tid >> 3) * KROW + (tid & 7) * 16);
        const unsigned skr = (unsigned)(((tid & 255) >> 2) * KROW + 128 + (tid & 3) * 16);
        const unsigned svt = (unsigned)((tid >> 3) * VROW + (tid & 7) * 16);
#define ATT_LOADK(rk, rr, kt_) do { if (MODE == 3 && (kt_) > 1) break; rk = *(const u32x4*)(gkn + (size_t)(kt_) * 64 * 512); rr = *(const u32x4*)(gkr + (size_t)(kt_) * 64 * 32); } while (0)
#define ATT_LOADV(rv, kt_) do { if (MODE == 3 && (kt_) > 1) break; rv = *(const u32x4*)(gvt + (size_t)(kt_) * 64); } while (0)
#define ATT_WRITEK(rk, rr, buf) do { LAS unsigned char* nb_ = lds + (buf) * KBUF; *(LAS u32x4*)(nb_ + skn) = rk; if (tid < 256) *(LAS u32x4*)(nb_ + skr) = rr; } while (0)
#define ATT_WRITEV(rv, buf) do { LAS u32x2* p_ = (LAS u32x2*)(ldsv + (buf) * VBUF + svt); u32x2 lo_ = {rv[0], rv[1]}, hi_ = {rv[2], rv[3]}; p_[0] = lo_; p_[1] = hi_; } while (0)
        u32x4 kK, kR, vV;
        ATT_LOADK(kK, kR, 0); ATT_LOADV(vV, 0);
        ATT_WRITEK(kK, kR, 0); ATT_WRITEV(vV, 0);
        ATT_LOADK(kK, kR, 1);
        ATT_WRITEK(kK, kR, 1);
        __syncthreads();
        f32x16 ot[2], sa[2], sb[2];
#pragma unroll
        for (int i = 0; i < 16; ++i) { ot[0][i] = 0.f; ot[1][i] = 0.f; }
        float mrun = -3.0e38f, lsum = 0.f;
        attn_qk<MODE>(lds, qf, sa, ql, hf);
        __syncthreads();
        for (int t = 0; t < nkt; t += 2) {
            if (t + 2 < nkt) ATT_LOADK(kK, kR, t + 2);
            ATT_LOADV(vV, t + 1);
            attn_qk<MODE>(lds + KBUF, qf, sb, ql, hf);
            __builtin_amdgcn_sched_barrier(0);
            attn_pv<MODE>(ldsv, sa, ot, mrun, lsum, ql, hf, lane);
            if (t + 2 < nkt) ATT_WRITEK(kK, kR, 0);
            ATT_WRITEV(vV, 1);
            __syncthreads();
            if (t + 3 < nkt) ATT_LOADK(kK, kR, t + 3);
            if (t + 2 < nkt) ATT_LOADV(vV, t + 2);
            if (t + 2 < nkt) attn_qk<MODE>(lds, qf, sa, ql, hf);
            __builtin_amdgcn_sched_barrier(0);
            attn_pv<MODE>(ldsv + VBUF, sb, ot, mrun, lsum, ql, hf, lane);
            if (t + 3 < nkt) ATT_WRITEK(kK, kR, 1);
            if (t + 2 < nkt) ATT_WRITEV(vV, 0);
            __syncthreads();
        }
#undef ATT_LOADK
#undef ATT_LOADV
#undef ATT_WRITEK
#undef ATT_WRITEV
        const float ltot = lsum + shx32(lsum, lane);
        const float inv = 1.0f / ltot;
        bf16_t* orow = AC + (size_t)qrow * 1024 + h * 64;
#pragma unroll
        for (int db = 0; db < 2; ++db)
#pragma unroll
            for (int g = 0; g < 4; ++g) {
                u32x2 o = {pk_bf16(ot[db][4 * g + 0] * inv, ot[db][4 * g + 1] * inv), pk_bf16(ot[db][4 * g + 2] * inv, ot[db][4 * g + 3] * inv)};
                if (MODE == 0 || (o[0] == 0x12345678u && o[1] == 0x9abcdef1u)) *(u32x2*)(orow + db * 32 + 8 * g + 4 * hf) = o;
            }
    }
}

__global__ void __launch_bounds__(NTHREADS, 2) mk_fwd(Args a) {
    extern __shared__ __attribute__((aligned(16))) unsigned char lds[];
    cg::grid_group grid = cg::this_grid();
    LAS unsigned char* ldsl = (LAS unsigned char*)lds;
    const int G = gridDim.x, bid = blockIdx.x;
    const int wid_s = __builtin_amdgcn_readfirstlane((int)(threadIdx.x >> 6));
    unsigned char* ws = a.ws;
    unsigned* gbar = (unsigned*)(ws + WS_CTL) + 128; unsigned gep = 0;

    REP(2) if (PH & 1) p0_phase(a, lds, wid_s);
    __threadfence();
    grid.sync();
    if (PH & 2) p1_phase(a, wid_s);
    gsync(gbar, ++gep, wid_s);

    for (int l = 0; l < DEPTH; ++l) {
        if (DUP & 128) { for (int q_ = 0; q_ < 20; ++q_) gsync(gbar, ++gep, wid_s); }
        REP(3) if (PH & 4) {
            pg8::SchedDense S{(const char*)(ws + WS_HB), (size_t)256 * 1024 * 2, (const char*)(ws + WS_WTIN) + (size_t)l * INWP * 1024 * 2, (size_t)256 * 1024 * 2, MR / 256, INWP / 256, G, bid, 0};
            EpiInproj E{(bf16_t*)(ws + WS_P), a.in[7] + (size_t)l * INW};
            pg8::gemm_phase(ldsl, 1024, 1024, S, E, wid_s);
        }
        if (DUP & 2048) {
            pg8::SchedDense S{(const char*)(ws + WS_HB), (size_t)256 * 1024 * 2, (const char*)(ws + WS_WTIN) + (size_t)l * INWP * 1024 * 2, (size_t)256 * 1024 * 2, MR / 256, INWP / 256, G, bid, 0};
            EpiNone E{(float*)(ws + WS_GWS)};
            pg8::gemm_phase(ldsl, 1024, 1024, S, E, wid_s);
        }
        if (DUP & 4096) {
            pg8::SchedDense S{(const char*)(ws + WS_HB), (size_t)256 * 1024 * 2, (const char*)(ws + WS_WTIN) + (size_t)l * INWP * 1024 * 2, (size_t)256 * 1024 * 2, MR / 256, INWP / 256, G, bid, 2};
            EpiNone E{(float*)(ws + WS_GWS)};
            pg8::gemm_phase(ldsl, 1024, 1024, S, E, wid_s);
        }
        gsync(gbar, ++gep, wid_s);
        REP(6) if (PH & 8) rowa_phase(a, l, wid_s);
        gsync(gbar, ++gep, wid_s);
        if (PH & 16) {
            const bool lastl = (l == DEPTH - 1);
            pg8::SchedQKV S{(const char*)(ws + WS_P), (const char*)(ws + WS_WTUQ) + (size_t)l * 768 * 256 * 2, (const char*)(ws + WS_P) + OFF_KV * 2, (const char*)(ws + WS_WTUKV) + (size_t)l * 1024 * 256 * 2,
                            (size_t)256 * INWP * 2, (size_t)256 * 256 * 2, lastl ? 128 : MR / 256, lastl ? 1 : 0, G, bid};
            EpiQKV E{EpiQ{(bf16_t*)(ws + WS_Q), (const float*)(ws + WS_RSQ), (const float2*)(ws + WS_ROPE)}, EpiKV{(bf16_t*)(ws + WS_KN), (bf16_t*)(ws + WS_VT), (const float*)(ws + WS_RSKV)}};
            pg8::gemm_phase(ldsl, 256, INWP, S, E, wid_s);
        }
        gsync(gbar, ++gep, wid_s);
        if (PH & 64) attn_phase<0>(a, l < DEPTH - 1, ldsl, wid_s);
        if (DUP & 1) attn_phase<AMODE>(a, l < DEPTH - 1, ldsl, wid_s);
        gsync(gbar, ++gep, wid_s);
        REP(5) {
        if (PH & 128) {
            pg8::SchedDense S{(const char*)(ws + WS_AC), (size_t)256 * 1024 * 2, (const char*)(ws + WS_WTOAB) + (size_t)l * 1024 * 1024 * 2, (size_t)256 * 512 * 2, (l == DEPTH - 1) ? 128 : MR / 256, 4, G, bid, (l == DEPTH - 1) ? 1 : 0};
            EpiMergeA E{(bf16_t*)(ws + WS_MG), (const bf16_t*)(ws + WS_P)};
            pg8::gemm_phase(ldsl, 512, 1024, S, E, wid_s);
        }
        if (PH & 128) {
            pg8::SchedDense S{(const char*)(ws + WS_AC) + 512 * 2, (size_t)256 * 1024 * 2, (const char*)(ws + WS_WTOAB) + (size_t)l * 1024 * 1024 * 2 + (size_t)1024 * 512 * 2, (size_t)256 * 512 * 2, (l == DEPTH - 1) ? 128 : MR / 256, 4, G, bid, (l == DEPTH - 1) ? 1 : 0};
            EpiMergeB E{(bf16_t*)(ws + WS_MG), (const bf16_t*)(ws + WS_P)};
            pg8::gemm_phase(ldsl, 512, 1024, S, E, wid_s);
        }
        }
        gsync(gbar, ++gep, wid_s);
        for (int rep_ = 0; rep_ <= (((DUP >> 8) & 1) && l == 0 ? 1 : 0); ++rep_) if (PH & 256) {
            pg8::SchedDense S{(const char*)(ws + WS_MG), (size_t)256 * 1024 * 2, (const char*)(ws + WS_WTO) + (size_t)l * 1024 * 1024 * 2, (size_t)256 * 1024 * 2, (l == DEPTH - 1) ? 128 : MR / 256, 4, G, bid, (l == DEPTH - 1) ? 1 : 0};
            EpiOut E{(float*)(ws + WS_RES), a.in[0], a.in[2], (const float*)(ws + WS_MOD) + (size_t)l * 5 * 6144, l};
            pg8::gemm_phase(ldsl, 1024, 1024, S, E, wid_s);
        }
        gsync(gbar, ++gep, wid_s);
        if (PH & 512) ln1_router_phase(a, l, lds, wid_s);
        gsync(gbar, ++gep, wid_s);
        REP(6) if (PH & 1024) gather_phase(a, l, lds, wid_s);
        gsync(gbar, ++gep, wid_s);
        REP(1) if (PH & 2048) {
            moe_prefix(a, l, lds, wid_s);
            const LAS int* ts = (const LAS int*)(ldsl + MISC_OFF);
            const int TM = ts[32];
            pg8::SchedMoe S{(const char*)(ws + WS_HB), (size_t)0, (const char*)(ws + WS_WTGU) + (size_t)l * NEXP * 2048 * 1024 * 2, (size_t)2048 * 1024 * 2, (size_t)256 * 1024 * 2, TM, 8, G, bid, ts};
            EpiGU E{(bf16_t*)(ws + WS_ACT), a.in[25] + (size_t)l * NEXP * 2048};
            {
                const int tid = mk_tid(wid_s); const int* RO = (const int*)(ws + WS_ROWOFF); LAS int* tab = (LAS int*)(ldsl + GTAB_OFF);
                pg8::Unit uu;
                for (int i = 0; i < 27 && S.next(i, uu); ++i) if (tid < 256) tab[i * 256 + tid] = RO[uu.pm * 256 + tid];
                __syncthreads();
            }
            pg8::gemm_phase<EpiGU, pg8::SchedMoe, true>(ldsl, 1024, 1024, S, E, wid_s, (const LAS int*)(ldsl + GTAB_OFF));
        }
        gsync(gbar, ++gep, wid_s);
        REP(1) if (PH & 4096) {
            const LAS int* ts = (const LAS int*)(ldsl + MISC_OFF);
            const int TM = ts[32];
            pg8::SchedMoe S{(const char*)(ws + WS_ACT), (size_t)256 * 1024 * 2, (const char*)(ws + WS_WTDN) + (size_t)l * NEXP * 1024 * 1024 * 2, (size_t)1024 * 1024 * 2, (size_t)256 * 1024 * 2, TM, 4, G, bid, ts};
            EpiDown E{(bf16_t*)(ws + WS_AS), a.in[27] + (size_t)l * NEXP * 1024, (const float*)(ws + WS_GWS)};
            pg8::gemm_phase(ldsl, 1024, 1024, S, E, wid_s);
        }
        gsync(gbar, ++gep, wid_s);
        for (int rep_ = 0; rep_ <= (((DUP >> 9) & 1) && l == DEPTH - 1 ? 1 : 0); ++rep_) if (PH & 8192) ln2_phase(a, l, wid_s);
        if (l + 1 < DEPTH) gsync(gbar, ++gep, wid_s);
    }
}

extern "C" void kernel_launch(void* const* d_in, const int* in_sizes, int n_in, void* d_out, int out_size, void* d_ws, size_t ws_size, hipStream_t stream) {
    static int grid = 0;
    if (grid == 0) {
        int dev = 0, cus = 0, per_cu = 0;
        if (hipGetDevice(&dev) != hipSuccess || hipDeviceGetAttribute(&cus, hipDeviceAttributeMultiprocessorCount, dev) != hipSuccess) { fprintf(stderr, "kernel_launch: device query failed\n"); grid = -1; return; }
        if (n_in != 28 || ws_size < WS_END) { fprintf(stderr, "kernel_launch: need 28 inputs and %zu B workspace; got %d, %zu\n", (size_t)WS_END, n_in, ws_size); grid = -1; return; }
        if (hipFuncSetAttribute((const void*)mk_fwd, hipFuncAttributeMaxDynamicSharedMemorySize, LDS_BYTES) != hipSuccess) { fprintf(stderr, "kernel_launch: hipFuncSetAttribute failed\n"); grid = -1; return; }
        if (hipOccupancyMaxActiveBlocksPerMultiprocessor(&per_cu, (const void*)mk_fwd, NTHREADS, LDS_BYTES) != hipSuccess || per_cu < 1) { fprintf(stderr, "kernel_launch: occupancy query says %d\n", per_cu); per_cu = 1; }
        (void)hipGetLastError();
        grid = cus;
        if (grid > 256) grid = 256;
        grid &= ~7;
    }
    if (grid <= 0) return;
    Args a{};
    for (int i = 0; i < 28; ++i) a.in[i] = (const float*)d_in[i];
    a.out = (float*)d_out; a.ws = (unsigned char*)d_ws;
    void* args[] = {&a};
    hipError_t e = hipLaunchCooperativeKernel((const void*)mk_fwd, dim3(grid), dim3(NTHREADS), args, LDS_BYTES, stream);
    if (e != hipSuccess) fprintf(stderr, "kernel_launch: cooperative launch failed: %s (grid %d)\n", hipGetErrorString(e), grid);
}
```

```cpp
#include <hip/hip_runtime.h>
#include <hip/hip_cooperative_groups.h>
#include <cstdio>
namespace cg = cooperative_groups;

#define LAS __attribute__((address_space(3)))
typedef unsigned short bf16_t;
typedef short bf16x8 __attribute__((ext_vector_type(8)));
typedef short bf16x4 __attribute__((ext_vector_type(4)));
typedef float f32x4 __attribute__((ext_vector_type(4)));
typedef float f32x16 __attribute__((ext_vector_type(16)));
typedef float f32x8 __attribute__((ext_vector_type(8)));
typedef float f32x2 __attribute__((ext_vector_type(2)));
typedef unsigned u32x4 __attribute__((ext_vector_type(4)));
typedef unsigned u32x2 __attribute__((ext_vector_type(2)));

constexpr int D = 1024, NBATCH = 4, SEQ = 8192, CTXL = 256, RPB = SEQ + CTXL, MR = NBATCH * RPB;
constexpr int DEPTH = 2, NH = 8, INW = 4000, INWP = 4096, NEXP = 32;
constexpr int OFF_KV = 256, OFF_KR = 384, OFF_CX = 416, OFF_CB = 928, OFF_CC = 1440, OFF_GA = 1952, OFF_GB = 2976;
constexpr float NORM_EPS = 1e-6f, DN_ALPHA = 1.41421356237f, SW_LIMIT = 7.0f, SW_ALPHA = 1.702f;
constexpr float QSCALE = 0.10206207261596575f * 1.4426950408889634f;
constexpr int SLOT_CAP = 143360;
constexpr int NTHREADS = 512;
constexpr int LDS_BYTES = 156 * 1024, MISC_OFF = 128 * 1024, GTAB_OFF = MISC_OFF + 1024;

constexpr size_t WS_CTL = 0;
constexpr size_t WS_MOD = 4096;
constexpr size_t WS_ROPE = WS_MOD + (size_t)DEPTH * 5 * 6144 * 4;
constexpr size_t WS_RSQ = WS_ROPE + (size_t)SEQ * 16 * 8;
constexpr size_t WS_RSKV = WS_RSQ + (size_t)MR * 4;
constexpr size_t WS_RE = WS_RSKV + (size_t)MR * 4;
constexpr size_t WS_RPOS = WS_RE + (size_t)MR * 16;
constexpr size_t WS_RG = WS_RPOS + (size_t)MR * 16;
constexpr size_t WS_SLOTOF = WS_RG + (size_t)MR * 16;
constexpr size_t WS_GWS = WS_SLOTOF + (size_t)MR * 16;
constexpr size_t WS_ROWOFF = WS_GWS + (size_t)SLOT_CAP * 4;
constexpr size_t WS_WTIN = WS_ROWOFF + (size_t)SLOT_CAP * 4;
constexpr size_t WS_WTUQ = WS_WTIN + (size_t)DEPTH * INWP * 1024 * 2;
constexpr size_t WS_WTUKV = WS_WTUQ + (size_t)DEPTH * 768 * 256 * 2;
constexpr size_t WS_WTOAB = WS_WTUKV + (size_t)DEPTH * 1024 * 256 * 2;
constexpr size_t WS_WTO = WS_WTOAB + (size_t)DEPTH * 1024 * 1024 * 2;
constexpr size_t WS_WTGU = WS_WTO + (size_t)DEPTH * 1024 * 1024 * 2;
constexpr size_t WS_WTDN = WS_WTGU + (size_t)DEPTH * NEXP * 2048 * 1024 * 2;
constexpr size_t WS_HB = WS_WTDN + (size_t)DEPTH * NEXP * 1024 * 1024 * 2;
constexpr size_t WS_P = WS_HB + (size_t)MR * 1024 * 2;
constexpr size_t WS_Q = WS_P + (size_t)MR * INWP * 2;
constexpr size_t WS_KN = WS_Q + (size_t)MR * 768 * 2;
constexpr size_t WS_KR = WS_KN + (size_t)MR * 512 * 2;
constexpr size_t WS_VT = WS_KR + (size_t)MR * 32 * 2;
constexpr size_t WS_AC = WS_VT + (size_t)MR * 512 * 2;
constexpr size_t WS_MG = WS_AC + (size_t)MR * 1024 * 2;
constexpr size_t WS_RES = WS_MG + (size_t)MR * 1024 * 2;
constexpr size_t WS_AS = WS_RES + (size_t)MR * 1024 * 4;
constexpr size_t WS_ACT = WS_AS + (size_t)SLOT_CAP * 1024 * 2;
constexpr size_t WS_END = WS_ACT + (size_t)SLOT_CAP * 1024 * 2;

#ifndef PH
#define PH 0xffff
#endif
#ifndef DUP
#define DUP 0
#endif
#ifndef AMODE
#define AMODE 0
#endif
#define REP(k) for (int rep_ = 0; rep_ <= ((DUP >> (k)) & 1); ++rep_)
struct Args { const float* in[28]; float* out; unsigned char* ws; };

__device__ __forceinline__ int lane_id() { int l; asm volatile("v_mbcnt_lo_u32_b32 %0, -1, 0\n\tv_mbcnt_hi_u32_b32 %0, -1, %0" : "=v"(l)); return l; }
__device__ __forceinline__ int mk_tid(int wid_s) { return wid_s * 64 + lane_id(); }
template <int M> __device__ __forceinline__ float swz(float v) { return __int_as_float(__builtin_amdgcn_ds_swizzle(__float_as_int(v), (M << 10) | 0x1f)); }
__device__ __forceinline__ float shx32(float v, int lane) { return __int_as_float(__builtin_amdgcn_ds_bpermute((lane ^ 32) << 2, __float_as_int(v))); }
__device__ __forceinline__ void gsync(unsigned* bar, unsigned epoch, int wid_s) {
    asm volatile("s_waitcnt vmcnt(0)" ::: "memory");
    __syncthreads();
    if (wid_s == 0) {
        if (lane_id() == 0) {
            __builtin_amdgcn_fence(__ATOMIC_RELEASE, "agent");
            const unsigned per = gridDim.x >> 3;
            const unsigned old = __hip_atomic_fetch_add(bar + 32u * (1u + (blockIdx.x & 7u)), 1u, __ATOMIC_RELAXED, __HIP_MEMORY_SCOPE_AGENT);
            if (old + 1u == epoch * per) __hip_atomic_fetch_add(bar, 1u, __ATOMIC_RELAXED, __HIP_MEMORY_SCOPE_AGENT);
            while (__hip_atomic_load(bar, __ATOMIC_RELAXED, __HIP_MEMORY_SCOPE_AGENT) < epoch * 8u) __builtin_amdgcn_s_sleep(1);
            __builtin_amdgcn_fence(__ATOMIC_ACQUIRE, "agent");
        }
    }
    __syncthreads();
}
__device__ __forceinline__ unsigned pk_bf16(float lo, float hi) { unsigned r; asm("v_cvt_pk_bf16_f32 %0, %1, %2" : "=v"(r) : "v"(lo), "v"(hi)); return r; }
__device__ __forceinline__ float bf_lo(unsigned u) { return __uint_as_float(u << 16); }
__device__ __forceinline__ float bf_hi(unsigned u) { return __uint_as_float(u & 0xffff0000u); }
__device__ __forceinline__ float bf2f(bf16_t b) { return __uint_as_float(((unsigned)b) << 16); }
__device__ __forceinline__ float fexp2(float x) { return __builtin_amdgcn_exp2f(x); }
__device__ __forceinline__ float frcp(float x) { return __builtin_amdgcn_rcpf(x); }
__device__ __forceinline__ float sigmoidf_(float x) { return frcp(1.0f + fexp2(-1.4426950408889634f * x)); }
__device__ __forceinline__ float max3f(float a, float b, float c) { float d; asm("v_max3_f32 %0, %1, %2, %3" : "=v"(d) : "v"(a), "v"(b), "v"(c)); return d; }
__device__ __forceinline__ float wave_sum(float v, int lane) {
    v += shx32(v, lane); v += swz<16>(v); v += swz<8>(v); v += swz<4>(v); v += swz<2>(v); v += swz<1>(v);
    return v;
}

namespace pg8 {
constexpr int BM = 256, BK = 64, HALF = 128, HTB = HALF * BK * 2;
__device__ __forceinline__ int lds_byte(int r, int c) { const int st = (r >> 4) * 2 + (c >> 5), rr = r & 15, cc = c & 31, ob = rr * 64 + cc * 2; return st * 1024 + (ob ^ (((ob >> 9) & 1) << 5)); }
__device__ __forceinline__ void stage_rc(int b, int& R, int& C) { const int st = b / 1024, sb = b % 1024, swz = sb ^ (((sb >> 9) & 1) << 5); R = (st >> 1) * 16 + swz / 64; C = (st & 1) * 32 + (swz % 64) / 2; }
__device__ __forceinline__ int perm32(int rho) { const int n = rho >> 4, i = rho & 15; return 8 * (i >> 2) + 4 * n + (i & 3); }

struct Unit { const char* A; const char* B; int pm, pn, e; };

__device__ __forceinline__ bool unit_coords(unsigned L, int nM, int nN, int& pm, int& pn) {
    const unsigned total = (unsigned)nM * (unsigned)nN; if (L >= total) return false;
    const unsigned fullg = (unsigned)nM >> 3, full = fullg * 8u * (unsigned)nN;
    if (L < full) {
        const unsigned x = L & 7u, q = L >> 3;
        if (nN == 16 && (fullg & 7u) == 0u) {
            const unsigned blk = q >> 5, in = q & 31u;
            pn = (int)((blk & 1u) * 8u + (in & 7u)); pm = (int)(((blk >> 1) * 4u + (in >> 3)) * 8u + x);
        } else { const unsigned qd = q / (unsigned)nN; pn = (int)(q - qd * (unsigned)nN); pm = (int)(qd * 8u + x); }
    }
    else { const unsigned r = (unsigned)nM & 7u, Lp = L - full; const unsigned qd = Lp / r; pm = (int)(fullg * 8u + (Lp - qd * r)); pn = (int)qd; }
    return true;
}
struct SchedDense {
    const char* A; size_t a_tstep; const char* B; size_t b_tstep; int nM, nN, G, c, skipctx;
    __device__ __forceinline__ bool next(int i, Unit& u) const {
        int pm, pn; if (!unit_coords((unsigned)(i * G + c), nM, nN, pm, pn)) return false;
        if (skipctx == 1) pm += (pm >> 5) + 1;
        if (skipctx == 2) { pm = 0; pn = 0; }
        u.pm = pm; u.pn = pn; u.e = 0; u.A = A + (size_t)pm * a_tstep; u.B = B + (size_t)pn * b_tstep; return true;
    }
};
struct SchedQKV {
    const char* Aq; const char* Bq; const char* Akv; const char* Bkv; size_t a_tstep, b_tstep; int nMq, skipq, G, c;
    __device__ __forceinline__ bool next(int i, Unit& u) const {
        const unsigned L = (unsigned)(i * G + c), nQ = (unsigned)nMq * 3u;
        int pm, pn;
        if (L < nQ) { unit_coords(L, nMq, 3, pm, pn); if (skipq) pm += (pm >> 5) + 1; u.e = 0; u.A = Aq + (size_t)pm * a_tstep; u.B = Bq + (size_t)pn * b_tstep; }
        else { if (!unit_coords(L - nQ, MR / 256, 4, pm, pn)) return false; u.e = 1; u.A = Akv + (size_t)pm * a_tstep; u.B = Bkv + (size_t)pn * b_tstep; }
        u.pm = pm; u.pn = pn; return true;
    }
};
struct SchedMoe {
    const char* A; size_t a_tstep; const char* W; size_t w_estep, b_tstep; int nM, nN, G, c; const LAS int* tstart;
    __device__ __forceinline__ bool next(int i, Unit& u) const {
        int pm, pn; if (!unit_coords((unsigned)(i * G + c), nM, nN, pm, pn)) return false;
        int e = 0;
#pragma unroll 1
        for (int k = 16; k >= 1; k >>= 1) if (tstart[e + k] <= pm) e += k;
        u.pm = pm; u.pn = pn; u.e = e; u.A = A + (size_t)pm * a_tstep; u.B = W + (size_t)e * w_estep + (size_t)pn * b_tstep; return true;
    }
};

typedef f32x4 Acc[2][2][4][2];

template <class Epi, class Sched, bool GATHER = false>
__device__ __forceinline__ void gemm_phase(LAS unsigned char* lds, const int K, const int lda, const Sched& S, const Epi& E, const int wid_s, const LAS int* rowoff = nullptr) {
    const int tid = mk_tid(wid_s);
    const int wid = wid_s, lane = tid & 63, wr = wid >> 2, wc = wid & 3, fr = lane & 15, fq = lane >> 4;
    const int nt = K / BK;
    unsigned voffA[2], voffB[2];
#pragma unroll
    for (int i = 0; i < 2; ++i) { int R, C; stage_rc(tid * 16 + i * 8192, R, C); const int Rb = (R & ~31) + perm32(R & 31);
        voffA[i] = (unsigned)(R * lda + C) * 2u; voffB[i] = (unsigned)(Rb * K + C) * 2u; }
    const size_t kstep = (size_t)(BK * 2);
    const size_t hstepA = GATHER ? (size_t)0 : (size_t)HALF * lda * 2, hstepB = (size_t)HALF * K * 2;
    int gR[2], gC[2];
#pragma unroll
    for (int i = 0; i < 2; ++i) stage_rc(tid * 16 + i * 8192, gR[i], gC[i]);
    unsigned gcur[2][2], gnxt[2][2];
#define PG8_GLOAD(dst, pm_) do { _Pragma("unroll") for (int h_ = 0; h_ < 2; ++h_) _Pragma("unroll") for (int i_ = 0; i_ < 2; ++i_) dst[h_][i_] = (unsigned)rowoff[(pm_) * 256 + h_ * 128 + gR[i_]] + (unsigned)gC[i_] * 2u; } while (0)
    const unsigned ldsw = (unsigned)wid * 1024u;
    const int aoff = lds_byte(wr * 64 + fr, fq * 8), boff = lds_byte(wc * 32 + fr, fq * 8);
#define PG8_SA(b, h) (((b) * 2 + (h)) * HTB)
#define PG8_SB(b, h) ((4 + (b) * 2 + (h)) * HTB)
#define PG8_STAGE(bufoff, gbase, voff) do { const char* _gb = (const char*)(gbase); asm volatile("" : "+s"(_gb)); _Pragma("unroll") for (int _i = 0; _i < 2; ++_i) \
        __builtin_amdgcn_global_load_lds((const unsigned*)(_gb + (voff)[_i]), (LAS unsigned*)(lds + (bufoff) + ldsw + _i * 8192), 16, 0, 0); } while (0)
#define PG8_STAGEA(bufoff, gbase, h_, usenext) do { if (GATHER) { unsigned go_[2] = {(usenext) ? gnxt[h_][0] : gcur[h_][0], (usenext) ? gnxt[h_][1] : gcur[h_][1]}; PG8_STAGE(bufoff, gbase, go_); } else PG8_STAGE(bufoff, (gbase) + (h_) * hstepA, voffA); } while (0)
#define PG8_LDA(dst, b, h) do { _Pragma("unroll") for (int m = 0; m < 4; ++m) _Pragma("unroll") for (int k = 0; k < 2; ++k) dst[m][k] = *(const LAS bf16x8*)(lds + PG8_SA(b, h) + aoff + m * 2048 + k * 1024); } while (0)
#define PG8_LDB(dst, b, h) do { _Pragma("unroll") for (int n = 0; n < 2; ++n) _Pragma("unroll") for (int k = 0; k < 2; ++k) dst[n][k] = *(const LAS bf16x8*)(lds + PG8_SB(b, h) + boff + n * 2048 + k * 1024); } while (0)
#define PG8_MMA(ai, bj, At, Bt) do { __builtin_amdgcn_s_setprio(1); _Pragma("unroll") for (int m = 0; m < 4; ++m) _Pragma("unroll") for (int n = 0; n < 2; ++n) _Pragma("unroll") for (int k = 0; k < 2; ++k) \
        acc[ai][bj][m][n] = __builtin_amdgcn_mfma_f32_16x16x32_bf16(Bt[n][k], At[m][k], acc[ai][bj][m][n], 0, 0, 0); __builtin_amdgcn_s_setprio(0); } while (0)
#define PG8_WAIT_V(n) asm volatile("s_waitcnt vmcnt(" #n ")" ::: "memory")
#define PG8_WAIT_L(n) asm volatile("s_waitcnt lgkmcnt(" #n ")" ::: "memory")
#define PG8_BAR __builtin_amdgcn_s_barrier()
#define PG8_SCHED __builtin_amdgcn_sched_barrier(0)
    Unit cur, nxt; int ui = 0;
    if (!S.next(0, cur)) return;
    Acc acc;
#pragma unroll
    for (int a = 0; a < 2; ++a)
#pragma unroll
        for (int b = 0; b < 2; ++b)
#pragma unroll
            for (int m = 0; m < 4; ++m)
#pragma unroll
                for (int n = 0; n < 2; ++n) acc[a][b][m][n] = (f32x4){0.f, 0.f, 0.f, 0.f};
    bf16x8 At[4][2], B0[2][2], B1[2][2];
    const char* cA = cur.A; const char* cB = cur.B;
    if (GATHER) { PG8_GLOAD(gcur, 0); }
    PG8_STAGE(PG8_SB(0, 0), cB, voffB); PG8_STAGEA(PG8_SA(0, 0), cA, 0, false); PG8_STAGE(PG8_SB(0, 1), cB + hstepB, voffB); PG8_STAGEA(PG8_SA(0, 1), cA, 1, false);
    if (wr == 1) PG8_BAR;
    PG8_WAIT_V(4); PG8_BAR;
    PG8_STAGE(PG8_SB(1, 0), cB + kstep, voffB); PG8_STAGEA(PG8_SA(1, 0), cA + kstep, 0, false); PG8_STAGE(PG8_SB(1, 1), cB + hstepB + kstep, voffB);
    PG8_WAIT_V(6); PG8_BAR;
    for (;;) {
        const bool has_next = S.next(ui + 1, nxt);
        const char* nA = has_next ? nxt.A : cA; const char* nB = has_next ? nxt.B : cB;
        if (GATHER) { if (has_next) PG8_GLOAD(gnxt, ui + 1); else { _Pragma("unroll") for (int h_ = 0; h_ < 2; ++h_) _Pragma("unroll") for (int i_ = 0; i_ < 2; ++i_) gnxt[h_][i_] = gcur[h_][i_]; } }
#pragma unroll 1
        for (int t = 0; t < nt; t += 2) {
            const bool last = (t == nt - 2);
            const char* a1 = cA + (size_t)(t + 1) * kstep;
            const char* a2 = last ? nA : cA + (size_t)(t + 2) * kstep; const char* b2 = last ? nB : cB + (size_t)(t + 2) * kstep;
            const char* a3 = a2 + kstep; const char* b3 = b2 + kstep;
            PG8_LDB(B0, 0, 0); PG8_SCHED; PG8_LDA(At, 0, 0); PG8_STAGEA(PG8_SA(1, 1), a1, 1, false);
            PG8_WAIT_L(8); PG8_BAR; PG8_WAIT_L(0); PG8_MMA(0, 0, At, B0); PG8_BAR; PG8_SCHED;
            PG8_LDB(B1, 0, 1); PG8_STAGE(PG8_SB(0, 0), b2, voffB);
            PG8_BAR; PG8_WAIT_L(0); PG8_MMA(0, 1, At, B1); PG8_BAR;
            PG8_LDA(At, 0, 1); PG8_STAGEA(PG8_SA(0, 0), a2, 0, last);
            PG8_BAR; PG8_WAIT_L(0); PG8_MMA(1, 0, At, B0); PG8_BAR; PG8_SCHED;
            PG8_STAGE(PG8_SB(0, 1), b2 + hstepB, voffB);
            PG8_WAIT_V(6); PG8_BAR; PG8_MMA(1, 1, At, B1); PG8_BAR;
            PG8_LDB(B0, 1, 0); PG8_SCHED; PG8_LDA(At, 1, 0); PG8_STAGEA(PG8_SA(0, 1), a2, 1, last);
            PG8_WAIT_L(8); PG8_BAR; PG8_WAIT_L(0); PG8_MMA(0, 0, At, B0); PG8_BAR; PG8_SCHED;
            PG8_LDB(B1, 1, 1); PG8_STAGE(PG8_SB(1, 0), b3, voffB);
            PG8_BAR; PG8_WAIT_L(0); PG8_MMA(0, 1, At, B1); PG8_BAR;
            PG8_LDA(At, 1, 1); PG8_STAGEA(PG8_SA(1, 0), a3, 0, last);
            PG8_BAR; PG8_WAIT_L(0); PG8_MMA(1, 0, At, B0); PG8_BAR; PG8_SCHED;
            PG8_STAGE(PG8_SB(1, 1), b3 + hstepB, voffB);
            PG8_WAIT_V(6); PG8_BAR; PG8_MMA(1, 1, At, B1); PG8_BAR;
        }
        E(acc, cur, wr, wc, fr, fq);
        if (!has_next) break;
#pragma unroll
        for (int a = 0; a < 2; ++a)
#pragma unroll
            for (int b = 0; b < 2; ++b)
#pragma unroll
                for (int m = 0; m < 4; ++m)
#pragma unroll
                    for (int n = 0; n < 2; ++n) acc[a][b][m][n] = (f32x4){0.f, 0.f, 0.f, 0.f};
        cur = nxt; cA = nA; cB = nB; ++ui;
        if (GATHER) { _Pragma("unroll") for (int h_ = 0; h_ < 2; ++h_) _Pragma("unroll") for (int i_ = 0; i_ < 2; ++i_) gcur[h_][i_] = gnxt[h_][i_]; }
    }
    PG8_WAIT_V(0);
    if (wr == 0) PG8_BAR;
    PG8_BAR;
#undef PG8_SA
#undef PG8_SB
#undef PG8_STAGE
#undef PG8_LDA
#undef PG8_STAGEA
#undef PG8_GLOAD
#undef PG8_LDB
#undef PG8_MMA
#undef PG8_WAIT_V
#undef PG8_WAIT_L
#undef PG8_BAR
#undef PG8_SCHED
}
}
using pg8::Acc; using pg8::Unit;

#define EPI_ROW(u, ai, m) ((u).pm * 256 + (ai) * 128 + wr * 64 + (m) * 16 + fr)
#define EPI_COL(u, bj) ((u).pn * 256 + (bj) * 128 + wc * 32 + 8 * fq)

#define EPI_PIN(r) asm volatile("" : "+v"(r))
#define EPI_FOR_BJ _Pragma("unroll") for (int bj = 0; bj < 2; ++bj)
#define EPI_FOR_AM _Pragma("unroll") for (int ai = 0; ai < 2; ++ai) _Pragma("unroll") for (int m = 0; m < 4; ++m)
__device__ __forceinline__ u32x4 pack8(const f32x4 a, const f32x4 b) { u32x4 o = {pk_bf16(a[0], a[1]), pk_bf16(a[2], a[3]), pk_bf16(b[0], b[1]), pk_bf16(b[2], b[3])}; return o; }

struct EpiInproj {
    static constexpr bool MID = false;
    bf16_t* P; const float* bias;
    __device__ __forceinline__ void operator()(Acc& acc, const Unit& u, int wr, int wc, int fr, int fq) const {
        f32x4 b0[2], b1[2];
        EPI_FOR_BJ { const int c0 = EPI_COL(u, bj); b0[bj] = (f32x4){0.f, 0.f, 0.f, 0.f}; b1[bj] = b0[bj];
            if (c0 < INW) { b0[bj] = *(const f32x4*)(bias + c0); b1[bj] = *(const f32x4*)(bias + c0 + 4); } }
        EPI_FOR_BJ { const int c0 = EPI_COL(u, bj);
            EPI_FOR_AM { int r = EPI_ROW(u, ai, m); EPI_PIN(r);
                *(u32x4*)(P + (size_t)r * INWP + c0) = pack8(acc[ai][bj][m][0] + b0[bj], acc[ai][bj][m][1] + b1[bj]);
                __builtin_amdgcn_sched_barrier(0); } }
    }
};

struct EpiNone {
    static constexpr bool MID = false;
    float* dummy;
    __device__ __forceinline__ void operator()(Acc& acc, const Unit& u, int wr, int wc, int fr, int fq) const {
        float t = 0.f;
        EPI_FOR_BJ EPI_FOR_AM t += acc[ai][bj][m][0][0] + acc[ai][bj][m][1][3];
        if (t == 12345.678f) dummy[0] = t;
    }
};

struct EpiQ {
    static constexpr bool MID = false;
    bf16_t* Q; const float* rs; const float2* cs;
    __device__ __forceinline__ void operator()(Acc& acc, const Unit& u, int wr, int wc, int fr, int fq) const {
        const bool is_ctx = (u.pm % 33) == 0;
        float sc[2][4];
        EPI_FOR_AM { const int r = EPI_ROW(u, ai, m); sc[ai][m] = rs[r] * QSCALE; }
        EPI_FOR_BJ {
            const int grp = (u.pn * 256 + bj * 128 + wc * 32) >> 5;
            const bool rope = ((grp % 3) == 2) && !is_ctx;
            EPI_FOR_AM { int r = EPI_ROW(u, ai, m); EPI_PIN(r);
                acc[ai][bj][m][0] *= sc[ai][m]; acc[ai][bj][m][1] *= sc[ai][m];
                if (rope) {
                    const int t = (r % RPB) - CTXL;
                    const float2* c2 = cs + (size_t)t * 16 + (fq >> 1) * 8;
#pragma unroll
                    for (int e = 0; e < 8; ++e) {
                        const float v = acc[ai][bj][m][e >> 2][e & 3];
                        const float pv = swz<16>(v);
                        const float2 csv = c2[e];
                        acc[ai][bj][m][e >> 2][e & 3] = v * csv.x + ((fq & 1) ? pv : -pv) * csv.y;
                    }
                }
                __builtin_amdgcn_sched_barrier(0); } }
        EPI_FOR_BJ { const int c0 = EPI_COL(u, bj);
            EPI_FOR_AM { int r = EPI_ROW(u, ai, m); EPI_PIN(r);
                *(u32x4*)(Q + (size_t)r * 768 + c0) = pack8(acc[ai][bj][m][0], acc[ai][bj][m][1]);
                __builtin_amdgcn_sched_barrier(0); } }
    }
};

struct EpiKV {
    static constexpr bool MID = false;
    bf16_t* KN; bf16_t* VT; const float* rs;
    __device__ __forceinline__ void operator()(Acc& acc, const Unit& u, int wr, int wc, int fr, int fq) const {
        float sc[2][4];
        EPI_FOR_AM { const int r = EPI_ROW(u, ai, m); sc[ai][m] = rs[r]; }
        EPI_FOR_BJ { const int c0 = EPI_COL(u, bj);
            EPI_FOR_AM { int r = EPI_ROW(u, ai, m); EPI_PIN(r);
                const f32x4 v0 = acc[ai][bj][m][0] * sc[ai][m], v1 = acc[ai][bj][m][1] * sc[ai][m];
                if (u.pn < 2) *(u32x4*)(KN + (size_t)r * 512 + c0) = pack8(v0, v1);
                else {
                    const int da = c0 - 512, hh = da >> 6, d = da & 63, b = r / RPB, j = r % RPB;
                    bf16_t* base = VT + ((size_t)((b * NH + hh) * 64 + d)) * RPB + j;
                    const u32x4 pk = pack8(v0, v1);
#pragma unroll
                    for (int e = 0; e < 4; ++e) { base[(size_t)(2 * e) * RPB] = (bf16_t)(pk[e] & 0xffffu); base[(size_t)(2 * e + 1) * RPB] = (bf16_t)(pk[e] >> 16); }
                }
                __builtin_amdgcn_sched_barrier(0); } }
    }
};

struct EpiQKV {
    static constexpr bool MID = false;
    EpiQ q; EpiKV kv;
    __device__ __forceinline__ void operator()(Acc& acc, const Unit& u, int wr, int wc, int fr, int fq) const {
        if (u.e == 0) q(acc, u, wr, wc, fr, fq); else kv(acc, u, wr, wc, fr, fq);
    }
};

struct EpiMergeA {
    static constexpr bool MID = false;
    bf16_t* MG; const bf16_t* P;
    __device__ __forceinline__ void operator()(Acc& acc, const Unit& u, int wr, int wc, int fr, int fq) const {
        EPI_FOR_BJ { const int c0 = EPI_COL(u, bj);
            EPI_FOR_AM { int r = EPI_ROW(u, ai, m); EPI_PIN(r);
                const u32x4 ga = *(const u32x4*)(P + (size_t)r * INWP + OFF_GA + c0);
#pragma unroll
                for (int e = 0; e < 8; ++e) acc[ai][bj][m][e >> 2][e & 3] *= sigmoidf_((e & 1) ? bf_hi(ga[e >> 1]) : bf_lo(ga[e >> 1]));
                __builtin_amdgcn_sched_barrier(0); } }
        EPI_FOR_BJ { const int c0 = EPI_COL(u, bj);
            EPI_FOR_AM { int r = EPI_ROW(u, ai, m); EPI_PIN(r);
                *(u32x4*)(MG + (size_t)r * 1024 + c0) = pack8(acc[ai][bj][m][0], acc[ai][bj][m][1]);
                __builtin_amdgcn_sched_barrier(0); } }
    }
};
struct EpiMergeB {
    static constexpr bool MID = false;
    bf16_t* MG; const bf16_t* P;
    __device__ __forceinline__ void operator()(Acc& acc, const Unit& u, int wr, int wc, int fr, int fq) const {
        EPI_FOR_BJ { const int c0 = EPI_COL(u, bj);
            EPI_FOR_AM { int r = EPI_ROW(u, ai, m); EPI_PIN(r);
                const u32x4 gb = *(const u32x4*)(P + (size_t)r * INWP + OFF_GB + c0);
                const u32x4 mo = *(const u32x4*)(MG + (size_t)r * 1024 + c0);
#pragma unroll
                for (int e = 0; e < 8; ++e) {
                    const float g = sigmoidf_((e & 1) ? bf_hi(gb[e >> 1]) : bf_lo(gb[e >> 1])), o = (e & 1) ? bf_hi(mo[e >> 1]) : bf_lo(mo[e >> 1]);
                    acc[ai][bj][m][e >> 2][e & 3] = o + acc[ai][bj][m][e >> 2][e & 3] * g;
                }
                __builtin_amdgcn_sched_barrier(0); } }
        EPI_FOR_BJ { const int c0 = EPI_COL(u, bj);
            EPI_FOR_AM { int r = EPI_ROW(u, ai, m); EPI_PIN(r);
                *(u32x4*)(MG + (size_t)r * 1024 + c0) = pack8(acc[ai][bj][m][0], acc[ai][bj][m][1]);
                __builtin_amdgcn_sched_barrier(0); } }
    }
};

struct EpiOut {
    static constexpr bool MID = false;
    float* RES; const float* x_in; const float* ctx_in; const float* mod; int layer;
    __device__ __forceinline__ void operator()(Acc& acc, const Unit& u, int wr, int wc, int fr, int fq) const {
        const int b = u.pm / 33; const bool is_ctx = (u.pm % 33) == 0;
        const float* g1 = mod + (size_t)(is_ctx ? 4 : b) * 6144 + 2048;
        f32x4 g0[2], g4[2];
        EPI_FOR_BJ { const int c0 = EPI_COL(u, bj); g0[bj] = *(const f32x4*)(g1 + c0); g4[bj] = *(const f32x4*)(g1 + c0 + 4); }
        EPI_FOR_BJ { const int c0 = EPI_COL(u, bj);
            EPI_FOR_AM { int r = EPI_ROW(u, ai, m); EPI_PIN(r);
                const float* xr;
                if (layer == 0) { const int j = r % RPB; xr = is_ctx ? ctx_in + ((size_t)(b * CTXL + j)) * 1024 : x_in + ((size_t)(b * SEQ + j - CTXL)) * 1024; }
                else xr = RES + (size_t)r * 1024;
                const f32x4 x0 = *(const f32x4*)(xr + c0), x4 = *(const f32x4*)(xr + c0 + 4);
                acc[ai][bj][m][0] = x0 * DN_ALPHA + g0[bj] * acc[ai][bj][m][0];
                acc[ai][bj][m][1] = x4 * DN_ALPHA + g4[bj] * acc[ai][bj][m][1];
                __builtin_amdgcn_sched_barrier(0); }
            EPI_FOR_AM { int r = EPI_ROW(u, ai, m); EPI_PIN(r);
                *(f32x4*)(RES + (size_t)r * 1024 + c0) = acc[ai][bj][m][0];
                *(f32x4*)(RES + (size_t)r * 1024 + c0 + 4) = acc[ai][bj][m][1];
                __builtin_amdgcn_sched_barrier(0); } }
    }
};

struct EpiGU {
    static constexpr bool MID = false;
    bf16_t* ACT; const float* bgu;
    __device__ __forceinline__ void operator()(Acc& acc, const Unit& u, int wr, int wc, int fr, int fq) const {
        const int cj = u.pn * 128 + wc * 32 + 8 * fq;
        const float* bb = bgu + (size_t)u.e * 2048;
        const f32x4 bg0 = *(const f32x4*)(bb + cj), bg1 = *(const f32x4*)(bb + cj + 4), bu0 = *(const f32x4*)(bb + 1024 + cj), bu1 = *(const f32x4*)(bb + 1024 + cj + 4);
        EPI_FOR_AM { int r = EPI_ROW(u, ai, m); EPI_PIN(r);
            float v[8];
#pragma unroll
            for (int e = 0; e < 8; ++e) {
                const float gb = (e < 4) ? bg0[e & 3] : bg1[e & 3], ub = (e < 4) ? bu0[e & 3] : bu1[e & 3];
                const float gate = fminf(acc[ai][0][m][e >> 2][e & 3] + gb, SW_LIMIT);
                const float up = fminf(fmaxf(acc[ai][1][m][e >> 2][e & 3] + ub, -SW_LIMIT), SW_LIMIT);
                v[e] = (up + 1.0f) * gate * sigmoidf_(SW_ALPHA * gate);
            }
            u32x4 o = {pk_bf16(v[0], v[1]), pk_bf16(v[2], v[3]), pk_bf16(v[4], v[5]), pk_bf16(v[6], v[7])};
            *(u32x4*)(ACT + (size_t)r * 1024 + cj) = o;
            __builtin_amdgcn_sched_barrier(0); }
    }
};

struct EpiDown {
    static constexpr bool MID = false;
    bf16_t* YS; const float* bdn; const float* gws;
    __device__ __forceinline__ void operator()(Acc& acc, const Unit& u, int wr, int wc, int fr, int fq) const {
        const float* bb = bdn + (size_t)u.e * 1024;
        float g[2][4]; f32x4 b0[2], b1[2];
        EPI_FOR_AM { const int r = EPI_ROW(u, ai, m); g[ai][m] = gws[r]; }
        EPI_FOR_BJ { const int c0 = EPI_COL(u, bj); b0[bj] = *(const f32x4*)(bb + c0); b1[bj] = *(const f32x4*)(bb + c0 + 4); }
        EPI_FOR_BJ { const int c0 = EPI_COL(u, bj);
            EPI_FOR_AM { int r = EPI_ROW(u, ai, m); EPI_PIN(r);
                *(u32x4*)(YS + (size_t)r * 1024 + c0) = pack8((acc[ai][bj][m][0] + b0[bj]) * g[ai][m], (acc[ai][bj][m][1] + b1[bj]) * g[ai][m]);
                __builtin_amdgcn_sched_barrier(0); } }
    }
};

struct ConvJob { const float* src; int ldsrc, k0, n0, Kvalid, Nvalid; const float* kscale; bf16_t* dst; int lddst; };

__device__ __forceinline__ void conv_tile4(const ConvJob (&J)[4], float* T  , const int tid) {
    f32x4 v[8];
    const int n4 = (tid & 63) * 4, jt = n4 >> 6, nn0 = n4 & 63;
    const float* const src0 = J[0].src; const int ld0 = J[0].ldsrc, kb0 = J[0].k0 + (tid >> 6), nb0 = J[0].n0 + n4, kv0 = J[0].Kvalid;
    const bool nok = nb0 < J[0].Nvalid;
#pragma unroll
    for (int it = 0; it < 8; ++it) {
        f32x4 t = {0.f, 0.f, 0.f, 0.f};
        if (nok && kb0 + 8 * it < kv0) t = *(const f32x4*)(src0 + (size_t)(kb0 + 8 * it) * ld0 + nb0);
        v[it] = t;
    }
    if (J[0].kscale) {
        const float* const ks = J[0].kscale;
#pragma unroll
        for (int it = 0; it < 8; ++it) { float sc = 1.0f; if (kb0 + 8 * it < kv0) sc = ks[kb0 + 8 * it]; v[it] *= sc; }
    }
    float* const tp0 = T + jt * 4160 + (tid >> 6) * 65 + nn0;
#pragma unroll
    for (int it = 0; it < 8; ++it) { float* tp = tp0 + it * 8 * 65; tp[0] = v[it][0]; tp[1] = v[it][1]; tp[2] = v[it][2]; tp[3] = v[it][3]; }
    __syncthreads();
#pragma unroll
    for (int j = 0; j < 4; ++j) {
        const int nn = tid >> 3, k8 = (tid & 7) * 8;
        const float* tp = T + j * 4160 + k8 * 65 + nn;
        u32x4 o = {pk_bf16(tp[0], tp[65]), pk_bf16(tp[130], tp[195]), pk_bf16(tp[260], tp[325]), pk_bf16(tp[390], tp[455])};
        *(u32x4*)(J[j].dst + (size_t)nn * J[j].lddst + k8) = o;
    }
    __syncthreads();
}

constexpr int CONV_PER_LAYER = 1024 + 48 + 64 + 256 + 256 + 16384 + 8192;

__device__ __forceinline__ void conv_decode(const Args& a, int job, ConvJob& J) {
    const int l = job / CONV_PER_LAYER; int r = job % CONV_PER_LAYER;
    unsigned char* ws = a.ws;
    J.kscale = nullptr; J.Kvalid = 1 << 30; J.Nvalid = 1 << 30;
    if (r < 1024) {
        const int kt = r >> 6, ntl = r & 63;
        J.src = a.in[6] + (size_t)l * 1024 * INW; J.ldsrc = INW; J.k0 = kt * 64; J.n0 = ntl * 64; J.Nvalid = INW;
        J.dst = (bf16_t*)(ws + WS_WTIN) + (size_t)l * INWP * 1024 + (size_t)(ntl * 64) * 1024 + kt * 64; J.lddst = 1024; return;
    }
    r -= 1024;
    if (r < 48) {
        const int kt = r / 12, ntl = r % 12;
        J.src = a.in[10] + (size_t)l * 256 * 768; J.ldsrc = 768; J.k0 = kt * 64; J.n0 = ntl * 64; J.kscale = a.in[8] + l * 256;
        J.dst = (bf16_t*)(ws + WS_WTUQ) + (size_t)l * 768 * 256 + (size_t)(ntl * 64) * 256 + kt * 64; J.lddst = 256; return;
    }
    r -= 48;
    if (r < 64) {
        const int kt = r >> 4, ntl = r & 15;
        J.src = (ntl < 8 ? a.in[11] : a.in[12]) + (size_t)l * 128 * 512; J.ldsrc = 512; J.k0 = kt * 64; J.n0 = (ntl & 7) * 64; J.Kvalid = 128; J.kscale = a.in[9] + l * 128;
        J.dst = (bf16_t*)(ws + WS_WTUKV) + (size_t)l * 1024 * 256 + (size_t)(ntl * 64) * 256 + kt * 64; J.lddst = 256; return;
    }
    r -= 64;
    if (r < 256) {
        const int kt = r >> 4, ntl = r & 15;
        J.src = (kt < 8 ? a.in[13] : a.in[16]) + (size_t)l * 512 * 1024; J.ldsrc = 1024; J.k0 = (kt & 7) * 64; J.n0 = ntl * 64;
        J.dst = (bf16_t*)(ws + WS_WTOAB) + (size_t)l * 1024 * 1024 + (size_t)(kt >> 3) * 1024 * 512 + (size_t)(ntl * 64) * 512 + (kt & 7) * 64; J.lddst = 512; return;
    }
    r -= 256;
    if (r < 256) {
        const int kt = r >> 4, ntl = r & 15;
        J.src = a.in[17] + (size_t)l * 1024 * 1024; J.ldsrc = 1024; J.k0 = kt * 64; J.n0 = ntl * 64;
        J.dst = (bf16_t*)(ws + WS_WTO) + (size_t)l * 1024 * 1024 + (size_t)(ntl * 64) * 1024 + kt * 64; J.lddst = 1024; return;
    }
    r -= 256;
    if (r < 16384) {
        const int e = r >> 9, rr = r & 511, kt = rr >> 5, ntl = rr & 31, n0 = ntl * 64;
        J.src = a.in[24] + ((size_t)(l * NEXP + e)) * 1024 * 2048; J.ldsrc = 2048; J.k0 = kt * 64; J.n0 = n0;
        const int jj = n0 & 1023, row0 = (jj >> 7) * 256 + (n0 >= 1024 ? 128 : 0) + (jj & 127);
        J.dst = (bf16_t*)(ws + WS_WTGU) + ((size_t)(l * NEXP + e)) * 2048 * 1024 + (size_t)row0 * 1024 + kt * 64; J.lddst = 1024; return;
    }
    r -= 16384;
    {
        const int e = r >> 8, rr = r & 255, kt = rr >> 4, ntl = rr & 15;
        J.src = a.in[26] + ((size_t)(l * NEXP + e)) * 1024 * 1024; J.ldsrc = 1024; J.k0 = kt * 64; J.n0 = ntl * 64;
        J.dst = (bf16_t*)(ws + WS_WTDN) + ((size_t)(l * NEXP + e)) * 1024 * 1024 + (size_t)(ntl * 64) * 1024 + kt * 64; J.lddst = 1024;
    }
}

__device__ __forceinline__ void p0_phase(const Args& a, unsigned char* ldsg, const int wid_s) {
    const int tid = mk_tid(wid_s), G = gridDim.x, bid = blockIdx.x;
    float* LF = (float*)ldsg;
    if (bid == 0) { ((int*)(a.ws + WS_CTL))[tid] = 0; ((int*)(a.ws + WS_CTL))[tid + 512] = 0; }
    for (int idx = bid * NTHREADS + tid; idx < SEQ * 16; idx += G * NTHREADS) {
        const int t = idx >> 4, i = idx & 15;
        const float pos = (float)((i < 8) ? (t >> 6) : (t & 63));
        const float fr_ = powf(10000.0f, -(float)(2 * (i & 7)) / 16.0f);
        const float ang = pos * fr_;
        const double turns = (double)ang * 0.15915494309189535;
        const float frac = (float)(turns - rint(turns));
        ((float2*)(a.ws + WS_ROPE))[idx] = make_float2(__builtin_amdgcn_cosf(frac), __builtin_amdgcn_sinf(frac));
    }
    for (int job = bid; job < DEPTH * 96; job += G) {
        const int l = job / 96, g = job % 96;
        for (int i = tid; i < 5 * 1024; i += NTHREADS) {
            const int m = i >> 10, k = i & 1023;
            const float c = (m < 4) ? a.in[1][m * 1024 + k] : a.in[3][k];
            LF[i] = c / (1.0f + __expf(-c));
        }
        __syncthreads();
        const int col = g * 64 + (tid & 63), kq = tid >> 6;
        const float* w = a.in[4] + (size_t)l * 1024 * 6144 + col;
        float s0 = 0.f, s1 = 0.f, s2 = 0.f, s3 = 0.f, s4 = 0.f;
#pragma unroll 32
        for (int k = kq * 128; k < kq * 128 + 128; ++k) {
            const float wv = w[(size_t)k * 6144];
            s0 += LF[k] * wv; s1 += LF[1024 + k] * wv; s2 += LF[2048 + k] * wv; s3 += LF[3072 + k] * wv; s4 += LF[4096 + k] * wv;
        }
        float* red = LF + 5120;
        red[(kq * 5 + 0) * 64 + (tid & 63)] = s0; red[(kq * 5 + 1) * 64 + (tid & 63)] = s1; red[(kq * 5 + 2) * 64 + (tid & 63)] = s2;
        red[(kq * 5 + 3) * 64 + (tid & 63)] = s3; red[(kq * 5 + 4) * 64 + (tid & 63)] = s4;
        __syncthreads();
        if (tid < 320) {
            const int m = tid >> 6, cc = tid & 63; float s = 0.f;
#pragma unroll
            for (int q = 0; q < 8; ++q) s += red[(q * 5 + m) * 64 + cc];
            ((float*)(a.ws + WS_MOD))[((size_t)(l * 5 + m)) * 6144 + g * 64 + cc] = s + a.in[5][l * 6144 + g * 64 + cc];
        }
        __syncthreads();
    }
    for (int job = bid * 4; job < DEPTH * CONV_PER_LAYER; job += G * 4) { ConvJob J[4]; conv_decode(a, job, J[0]); conv_decode(a, job + 1, J[1]); conv_decode(a, job + 2, J[2]); conv_decode(a, job + 3, J[3]); conv_tile4(J, LF, tid); }
}

__device__ __forceinline__ void p1_phase(const Args& a, const int wid_s) {
    const int tid_ = mk_tid(wid_s);
    const int lane = tid_ & 63, gw = blockIdx.x * 8 + (tid_ >> 6), nw = gridDim.x * 8;
    const float* mod = (const float*)(a.ws + WS_MOD);
    bf16_t* HB = (bf16_t*)(a.ws + WS_HB);
    f32x4 xn[4];
    const float* const x_in = a.in[0]; const float* const c_in = a.in[2];
#define P1_LOAD(Rq) do { const int Rc_ = min((Rq), MR - 1); const int b_ = Rc_ / RPB, j_ = Rc_ % RPB; \
        const float* src_ = (j_ < CTXL) ? c_in + ((size_t)(b_ * CTXL + j_)) * 1024 : x_in + ((size_t)(b_ * SEQ + j_ - CTXL)) * 1024; \
        _Pragma("unroll") for (int i = 0; i < 4; ++i) xn[i] = *(const f32x4*)(src_ + (lane + 64 * i) * 4); } while (0)
    P1_LOAD(gw);
    for (int R = gw; R < MR; R += nw) {
        const int b = R / RPB, j = R % RPB;
        const float* md = mod + (size_t)((j < CTXL) ? 4 : b) * 6144;
        f32x4 xc[4];
#pragma unroll
        for (int i = 0; i < 4; ++i) xc[i] = xn[i];
        P1_LOAD(R + nw);
#pragma unroll
        for (int i = 0; i < 4; ++i) {
            const int k = (lane + 64 * i) * 4;
            const f32x4 sh = *(const f32x4*)(md + k), sc = *(const f32x4*)(md + 1024 + k);
            const f32x4 h = xc[i] * (sc + 1.0f) + sh;
            u32x2 o = {pk_bf16(h[0], h[1]), pk_bf16(h[2], h[3])};
            *(u32x2*)(HB + (size_t)R * 1024 + k) = o;
        }
    }
#undef P1_LOAD
}

__device__ __forceinline__ void rowa_phase(const Args& a, int l, const int wid_s) {
    const int tid_ = mk_tid(wid_s);
    const int lane = tid_ & 63, gw = blockIdx.x * 8 + (tid_ >> 6), nw = gridDim.x * 8;
    const bf16_t* P = (const bf16_t*)(a.ws + WS_P);
    float* rsq = (float*)(a.ws + WS_RSQ); float* rskv = (float*)(a.ws + WS_RSKV);
    bf16_t* KR = (bf16_t*)(a.ws + WS_KR); bf16_t* AC = (bf16_t*)(a.ws + WS_AC);
    const float2* cs = (const float2*)(a.ws + WS_ROPE);
    const float* cw = a.in[14] + (size_t)l * 3 * 512; const float* cb = a.in[15] + (size_t)l * 512;
    const int c8 = lane * 8;
    float w0[8], w1[8], w2[8], bs[8];
#pragma unroll
    for (int e = 0; e < 8; ++e) { w0[e] = cw[c8 + e]; w1[e] = cw[512 + c8 + e]; w2[e] = cw[1024 + c8 + e]; bs[e] = cb[c8 + e]; }
    u32x2 nqa; unsigned nka; bf16_t nkr; u32x4 nuc, nbc, ncc, nup, ncp, nun, ncn;
#define RA_LOAD(Rq) do { const int Rc_ = min((Rq), MR - 1); const bf16_t* pr_ = P + (size_t)Rc_ * INWP; const int j_ = Rc_ % RPB; \
        const bool hp_ = (j_ != 0) && (j_ != CTXL), hn_ = (j_ != CTXL - 1) && (j_ != RPB - 1); const u32x4 z_ = {0u, 0u, 0u, 0u}; \
        nqa = *(const u32x2*)(pr_ + lane * 4); nka = *(const unsigned*)(pr_ + OFF_KV + lane * 2); nkr = pr_[OFF_KR + (lane & 31)]; \
        nuc = *(const u32x4*)(pr_ + OFF_CX + c8); nbc = *(const u32x4*)(pr_ + OFF_CB + c8); ncc = *(const u32x4*)(pr_ + OFF_CC + c8); \
        nup = hp_ ? *(const u32x4*)(pr_ - INWP + OFF_CX + c8) : z_; ncp = hp_ ? *(const u32x4*)(pr_ - INWP + OFF_CC + c8) : z_; \
        nun = hn_ ? *(const u32x4*)(pr_ + INWP + OFF_CX + c8) : z_; ncn = hn_ ? *(const u32x4*)(pr_ + INWP + OFF_CC + c8) : z_; } while (0)
    RA_LOAD(gw);
    for (int R = gw; R < MR; R += nw) {
        const int j = R % RPB;
        const u32x2 qa = nqa; const unsigned ka = nka; const bf16_t krv = nkr;
        const u32x4 uc = nuc, bc = nbc, cc = ncc, up = nup, cp = ncp, un = nun, cn = ncn;
        RA_LOAD(R + nw);
        float sq = bf_lo(qa[0]) * bf_lo(qa[0]) + bf_hi(qa[0]) * bf_hi(qa[0]) + bf_lo(qa[1]) * bf_lo(qa[1]) + bf_hi(qa[1]) * bf_hi(qa[1]);
        float sk = bf_lo(ka) * bf_lo(ka) + bf_hi(ka) * bf_hi(ka);
        sq = wave_sum(sq, lane); sk = wave_sum(sk, lane);
        if (lane == 0) { rsq[R] = rsqrtf(sq * (1.0f / 256.0f) + NORM_EPS); rskv[R] = rsqrtf(sk * (1.0f / 128.0f) + NORM_EPS); }
        {
            const float v = bf2f(krv);
            const float pv = swz<8>(v);
            float o = v;
            if (j >= CTXL) { const int i = lane & 31; const float2 c2 = cs[(size_t)(j - CTXL) * 16 + (i >> 4) * 8 + (i & 7)]; o = v * c2.x + (((i >> 3) & 1) ? pv : -pv) * c2.y; }
            const float o2 = swz<1>(o);
            if (lane < 32 && !(lane & 1)) *(unsigned*)(KR + (size_t)R * 32 + lane) = pk_bf16(o, o2);
        }
        float y[8];
#pragma unroll
        for (int e = 0; e < 8; ++e) {
            const int q = e >> 1;
            const float zc = (e & 1) ? bf_hi(uc[q]) * bf_hi(cc[q]) : bf_lo(uc[q]) * bf_lo(cc[q]);
            const float zp = (e & 1) ? bf_hi(up[q]) * bf_hi(cp[q]) : bf_lo(up[q]) * bf_lo(cp[q]);
            const float zn = (e & 1) ? bf_hi(un[q]) * bf_hi(cn[q]) : bf_lo(un[q]) * bf_lo(cn[q]);
            const float bg = (e & 1) ? bf_hi(bc[q]) : bf_lo(bc[q]);
            y[e] = bg * (w0[e] * zp + w1[e] * zc + w2[e] * zn + bs[e]);
        }
        u32x4 o = {pk_bf16(y[0], y[1]), pk_bf16(y[2], y[3]), pk_bf16(y[4], y[5]), pk_bf16(y[6], y[7])};
        *(u32x4*)(AC + (size_t)R * 1024 + 512 + c8) = o;
    }
#undef RA_LOAD
}

__device__ __forceinline__ void router_tail(const f32x16 plo, const f32x16 phi, const int lane, const float* br_, const bool live, const int lrow, int* lcnt, int* rec_e, int* rec_p, float* rec_g) {
    const bool u5 = (lane & 32) != 0, u4 = (lane & 16) != 0, u3 = (lane & 8) != 0, u2 = (lane & 4) != 0, u1 = (lane & 2) != 0;
    f32x16 k16 = u5 ? phi : plo; const f32x16 s16 = u5 ? plo : phi;
#pragma unroll
    for (int i = 0; i < 16; ++i) k16[i] += shx32(s16[i], lane);
    f32x8 k8 = u4 ? k16.hi : k16.lo; const f32x8 s8 = u4 ? k16.lo : k16.hi;
#pragma unroll
    for (int i = 0; i < 8; ++i) k8[i] += swz<16>(s8[i]);
    f32x4 k4 = u3 ? k8.hi : k8.lo; const f32x4 s4 = u3 ? k8.lo : k8.hi;
#pragma unroll
    for (int i = 0; i < 4; ++i) k4[i] += swz<8>(s4[i]);
    f32x2 k2 = u2 ? k4.hi : k4.lo; const f32x2 s2 = u2 ? k4.lo : k4.hi;
#pragma unroll
    for (int i = 0; i < 2; ++i) k2[i] += swz<4>(s2[i]);
    float k1 = u1 ? k2.y : k2.x; const float s1 = u1 ? k2.x : k2.y;
    k1 += swz<2>(s1);
    const int myE = lane >> 1;
    const float mylog = k1 + swz<1>(k1) + br_[myE];
    int rank = 0;
#pragma unroll
    for (int e = 0; e < 32; ++e) {
        const float le = __uint_as_float(__builtin_amdgcn_readlane(__float_as_uint(mylog), 2 * e));
        rank += ((le > mylog) || (le == mylog && e < myE)) ? 1 : 0;
    }
    const bool even = !(lane & 1);
    const unsigned long long m0 = __ballot(even && rank == 0), m1 = __ballot(even && rank == 1), m2 = __ballot(even && rank == 2), m3 = __ballot(even && rank == 3);
    const float v0 = __uint_as_float(__builtin_amdgcn_readlane(__float_as_uint(mylog), __builtin_ctzll(m0)));
    const float v1 = __uint_as_float(__builtin_amdgcn_readlane(__float_as_uint(mylog), __builtin_ctzll(m1)));
    const float v2 = __uint_as_float(__builtin_amdgcn_readlane(__float_as_uint(mylog), __builtin_ctzll(m2)));
    const float v3 = __uint_as_float(__builtin_amdgcn_readlane(__float_as_uint(mylog), __builtin_ctzll(m3)));
    const float inv = 1.0f / (1.0f + __expf(v1 - v0) + __expf(v2 - v0) + __expf(v3 - v0));
    if (live && even && rank < 4) {
        const float g = __expf(mylog - v0) * inv;
        const int lp = atomicAdd(&lcnt[myE], 1);
        const int li = lrow * 4 + rank;
        rec_e[li] = myE; rec_p[li] = lp; rec_g[li] = g;
    }
}

__device__ __forceinline__ void ln1_router_phase(const Args& a, int l, unsigned char* ldsg, const int wid_s) {
    const int tid_ = mk_tid(wid_s);
    const int tid = tid_, lane = tid & 63, wid = tid >> 6, G = gridDim.x, bid = blockIdx.x;
    float* WT = (float*)ldsg;
    int* lcnt = (int*)(ldsg + MISC_OFF);
    int* lbase = lcnt + 32;
    int* rec_e = lbase + 32;
    int* rec_p = rec_e + 1024;
    float* rec_g = (float*)(rec_p + 1024);
    const float* wr_ = a.in[22] + (size_t)l * 1024 * 32; const float* br_ = a.in[23] + l * 32;
    {
        f32x4 wv[16];
#pragma unroll
        for (int j = 0; j < 16; ++j) wv[j] = *(const f32x4*)(wr_ + (size_t)(tid + NTHREADS * j) * 4);
#pragma unroll
        for (int j = 0; j < 16; ++j) { const int idx = (tid + NTHREADS * j) * 4, k = idx >> 5, e = idx & 31;
#pragma unroll
            for (int c = 0; c < 4; ++c) WT[(e + c) * 1024 + k] = wv[j][c]; }
    }
    if (tid < 32) lcnt[tid] = 0;
    __syncthreads();
    const int rpb = (MR + G - 1) / G, r0 = bid * rpb, r1 = min(MR, r0 + rpb);
    float* RES = (float*)(a.ws + WS_RES); bf16_t* HB = (bf16_t*)(a.ws + WS_HB);
    const float* mod = (const float*)(a.ws + WS_MOD) + (size_t)l * 5 * 6144;
    const float* lg_ = a.in[18] + l * 1024; const float* lb_ = a.in[19] + l * 1024;
    const bool lastl = (l == DEPTH - 1);
    f32x4 na[4], nb[4];
#define L1_LOAD(Rq) do { const int Ra_ = min((Rq), MR - 1), Rb_ = min((Rq) + 8, MR - 1); _Pragma("unroll") for (int i = 0; i < 4; ++i) { \
        na[i] = *(const f32x4*)(RES + (size_t)Ra_ * 1024 + (lane + 64 * i) * 4); nb[i] = *(const f32x4*)(RES + (size_t)Rb_ * 1024 + (lane + 64 * i) * 4); } } while (0)
    L1_LOAD(r0 + wid);
    for (int Ra = r0 + wid; Ra < r1; Ra += 16) {
        const bool has2 = (Ra + 8 < r1);
        const int Rb = has2 ? Ra + 8 : Ra;
        f32x4 va[4], vb[4];
#pragma unroll
        for (int i = 0; i < 4; ++i) { va[i] = na[i]; vb[i] = has2 ? nb[i] : na[i]; }
        L1_LOAD(Ra + 16);
        const int ja = Ra % RPB, jb = Rb % RPB;
        const bool livea = !(lastl && ja < CTXL), liveb = has2 && !(lastl && jb < CTXL);
        if (!livea && !liveb) continue;
        const float* mda = mod + (size_t)((ja < CTXL) ? 4 : Ra / RPB) * 6144;
        const float* mdb = mod + (size_t)((jb < CTXL) ? 4 : Rb / RPB) * 6144;
        float sa_ = 0.f, sb_ = 0.f;
#pragma unroll
        for (int i = 0; i < 4; ++i) { sa_ += va[i][0] + va[i][1] + va[i][2] + va[i][3]; sb_ += vb[i][0] + vb[i][1] + vb[i][2] + vb[i][3]; }
        const float mua = wave_sum(sa_, lane) * (1.0f / 1024.0f), mub = wave_sum(sb_, lane) * (1.0f / 1024.0f);
        float qa = 0.f, qb = 0.f;
#pragma unroll
        for (int i = 0; i < 4; ++i) { va[i] = va[i] - mua; vb[i] = vb[i] - mub; qa += va[i][0] * va[i][0] + va[i][1] * va[i][1] + va[i][2] * va[i][2] + va[i][3] * va[i][3]; qb += vb[i][0] * vb[i][0] + vb[i][1] * vb[i][1] + vb[i][2] * vb[i][2] + vb[i][3] * vb[i][3]; }
        const float rsa = rsqrtf(wave_sum(qa, lane) * (1.0f / 1024.0f) + NORM_EPS), rsb = rsqrtf(wave_sum(qb, lane) * (1.0f / 1024.0f) + NORM_EPS);
        f32x2 hp[4][4];
#pragma unroll
        for (int i = 0; i < 4; ++i) {
            const int k = (lane + 64 * i) * 4;
            const f32x4 gg = *(const f32x4*)(lg_ + k), bb = *(const f32x4*)(lb_ + k);
            const f32x4 xa = va[i] * rsa * gg + bb, xb = vb[i] * rsb * gg + bb;
            const f32x4 ha = xa * (*(const f32x4*)(mda + 4096 + k) + 1.0f) + *(const f32x4*)(mda + 3072 + k);
            const f32x4 hb = xb * (*(const f32x4*)(mdb + 4096 + k) + 1.0f) + *(const f32x4*)(mdb + 3072 + k);
#pragma unroll
            for (int c = 0; c < 4; ++c) hp[i][c] = (f32x2){ha[c], hb[c]};
            if (livea) { *(f32x4*)(RES + (size_t)Ra * 1024 + k) = xa; u32x2 o = {pk_bf16(ha[0], ha[1]), pk_bf16(ha[2], ha[3])}; *(u32x2*)(HB + (size_t)Ra * 1024 + k) = o; }
            if (liveb) { *(f32x4*)(RES + (size_t)Rb * 1024 + k) = xb; u32x2 o = {pk_bf16(hb[0], hb[1]), pk_bf16(hb[2], hb[3])}; *(u32x2*)(HB + (size_t)Rb * 1024 + k) = o; }
        }
        f32x2 pl2[32];
#pragma unroll
        for (int e = 0; e < 32; ++e) {
            f32x2 acc2 = {0.f, 0.f};
#pragma unroll
            for (int i = 0; i < 4; ++i) {
                const f32x4 w = *(const f32x4*)(WT + e * 1024 + (lane + 64 * i) * 4);
#pragma unroll
                for (int c = 0; c < 4; ++c) acc2 = __builtin_elementwise_fma(hp[i][c], (f32x2){w[c], w[c]}, acc2);
            }
            pl2[e] = acc2;
            if ((e & 3) == 3) __builtin_amdgcn_sched_barrier(0);
        }
        {
            const f32x16 plo = {pl2[0].x, pl2[1].x, pl2[2].x, pl2[3].x, pl2[4].x, pl2[5].x, pl2[6].x, pl2[7].x, pl2[8].x, pl2[9].x, pl2[10].x, pl2[11].x, pl2[12].x, pl2[13].x, pl2[14].x, pl2[15].x};
            const f32x16 phi = {pl2[16].x, pl2[17].x, pl2[18].x, pl2[19].x, pl2[20].x, pl2[21].x, pl2[22].x, pl2[23].x, pl2[24].x, pl2[25].x, pl2[26].x, pl2[27].x, pl2[28].x, pl2[29].x, pl2[30].x, pl2[31].x};
            router_tail(plo, phi, lane, br_, livea, Ra - r0, lcnt, rec_e, rec_p, rec_g);
        }
        {
            const f32x16 plo = {pl2[0].y, pl2[1].y, pl2[2].y, pl2[3].y, pl2[4].y, pl2[5].y, pl2[6].y, pl2[7].y, pl2[8].y, pl2[9].y, pl2[10].y, pl2[11].y, pl2[12].y, pl2[13].y, pl2[14].y, pl2[15].y};
            const f32x16 phi = {pl2[16].y, pl2[17].y, pl2[18].y, pl2[19].y, pl2[20].y, pl2[21].y, pl2[22].y, pl2[23].y, pl2[24].y, pl2[25].y, pl2[26].y, pl2[27].y, pl2[28].y, pl2[29].y, pl2[30].y, pl2[31].y};
            router_tail(plo, phi, lane, br_, liveb, Rb - r0, lcnt, rec_e, rec_p, rec_g);
        }
    }
#undef L1_LOAD
    __syncthreads();
    if (tid < 32) lbase[tid] = atomicAdd((int*)(a.ws + WS_CTL) + l * 32 + tid, lcnt[tid]);
    __syncthreads();
    int* RE = (int*)(a.ws + WS_RE); int* RP = (int*)(a.ws + WS_RPOS); float* RG = (float*)(a.ws + WS_RG);
    for (int i = tid; i < (r1 - r0) * 4; i += NTHREADS) {
        if (lastl && ((r0 + (i >> 2)) % RPB) < CTXL) continue;
        const int e = rec_e[i];
        RE[(size_t)r0 * 4 + i] = e; RP[(size_t)r0 * 4 + i] = lbase[e] + rec_p[i]; RG[(size_t)r0 * 4 + i] = rec_g[i];
    }
    __syncthreads();
}

__device__ __forceinline__ void moe_prefix(const Args& a, int l, unsigned char* ldsg, const int wid_s) {
    int* ts = (int*)(ldsg + MISC_OFF);
    __syncthreads();
    if (wid_s == 0 && lane_id() == 0) {
        const int* cnt = (const int*)(a.ws + WS_CTL) + l * 32; int acc_ = 0;
#pragma unroll 1
        for (int e = 0; e < 32; ++e) { ts[e] = acc_; ts[40 + e] = __hip_atomic_load(cnt + e, __ATOMIC_RELAXED, __HIP_MEMORY_SCOPE_AGENT); acc_ += (__hip_atomic_load(cnt + e, __ATOMIC_RELAXED, __HIP_MEMORY_SCOPE_AGENT) + 255) >> 8; }
        ts[32] = acc_;
    }
    __syncthreads();
}

__device__ __forceinline__ void gather_phase(const Args& a, int l, unsigned char* ldsg, const int wid_s) {
    moe_prefix(a, l, ldsg, wid_s);
    const int* ts = (const int*)(ldsg + MISC_OFF);
    const int tid = mk_tid(wid_s);
    const int* RE = (const int*)(a.ws + WS_RE); const int* RP = (const int*)(a.ws + WS_RPOS); const float* RG = (const float*)(a.ws + WS_RG);
    int* SO = (int*)(a.ws + WS_SLOTOF); float* GWS = (float*)(a.ws + WS_GWS); int* RO = (int*)(a.ws + WS_ROWOFF);
    const int G = gridDim.x;
    for (int i = blockIdx.x * NTHREADS + tid; i < MR * 4; i += G * NTHREADS) {
        const int R = i >> 2;
        if (l == DEPTH - 1 && (R % RPB) < CTXL) continue;
        const int slot = ts[RE[i] & 31] * 256 + RP[i];
        SO[i] = slot; GWS[slot] = RG[i]; RO[slot] = R * 2048;
    }
    for (int e = blockIdx.x; e < NEXP; e += G) {
        const int beg = ts[e] * 256 + ts[40 + e], end = ts[e + 1] * 256;
        for (int sl = beg + tid; sl < end; sl += NTHREADS) { RO[sl] = 0; GWS[sl] = 0.f; }
    }
}

__device__ __forceinline__ void ln2_phase(const Args& a, int l, const int wid_s) {
    const int tid_ = mk_tid(wid_s);
    const int lane = tid_ & 63, gw = blockIdx.x * 8 + (tid_ >> 6), nw = gridDim.x * 8;
    float* RES = (float*)(a.ws + WS_RES); bf16_t* HB = (bf16_t*)(a.ws + WS_HB); const bf16_t* YS = (const bf16_t*)(a.ws + WS_AS);
    const int* SO = (const int*)(a.ws + WS_SLOTOF);
    const float* mod = (const float*)(a.ws + WS_MOD) + (size_t)l * 5 * 6144;
    const float* modn = (const float*)(a.ws + WS_MOD) + (size_t)((l + 1) % DEPTH) * 5 * 6144;
    const float* lg_ = a.in[20] + l * 1024; const float* lb_ = a.in[21] + l * 1024;
    const bool last = (l == DEPTH - 1);
    int sl1[4], sl2[4];
    u32x2 ysn[4][4]; f32x4 rsn[4];
#define LN2_SLOTS(dst, Rq) do { const int Rc_ = min((Rq), MR - 1); _Pragma("unroll") for (int k = 0; k < 4; ++k) dst[k] = SO[Rc_ * 4 + k]; } while (0)
#define LN2_ROWS(Rq, slq) do { const int Rc_ = min((Rq), MR - 1); const bool skip_ = last && (Rc_ % RPB) < CTXL; _Pragma("unroll") for (int i = 0; i < 4; ++i) { const int k0_ = (lane + 64 * i) * 4; \
        rsn[i] = *(const f32x4*)(RES + (size_t)Rc_ * 1024 + k0_); _Pragma("unroll") for (int k = 0; k < 4; ++k) ysn[i][k] = *(const u32x2*)(YS + (size_t)(skip_ ? 0 : slq[k]) * 1024 + k0_); } } while (0)
    LN2_SLOTS(sl1, gw); LN2_SLOTS(sl2, gw + nw);
    LN2_ROWS(gw, sl1);
#pragma unroll
    for (int k = 0; k < 4; ++k) sl1[k] = sl2[k];
    for (int R = gw; R < MR; R += nw) {
        u32x2 ys[4][4]; f32x4 v[4];
#pragma unroll
        for (int i = 0; i < 4; ++i) { v[i] = rsn[i];
#pragma unroll
            for (int k = 0; k < 4; ++k) ys[i][k] = ysn[i][k]; }
        LN2_SLOTS(sl2, R + 2 * nw);
        LN2_ROWS(R + nw, sl1);
#pragma unroll
        for (int k = 0; k < 4; ++k) sl1[k] = sl2[k];
        const int b = R / RPB, j = R % RPB; const int mi = (j < CTXL) ? 4 : b;
        if (last && j < CTXL) continue;
        const float* md = mod + (size_t)mi * 6144;
        float* rr = RES + (size_t)R * 1024;
        float s = 0.f;
#pragma unroll
        for (int i = 0; i < 4; ++i) {
            const int k0 = (lane + 64 * i) * 4;
            f32x4 f = {0.f, 0.f, 0.f, 0.f};
#pragma unroll
            for (int k = 0; k < 4; ++k) { const u32x2 y = ys[i][k]; f[0] += bf_lo(y[0]); f[1] += bf_hi(y[0]); f[2] += bf_lo(y[1]); f[3] += bf_hi(y[1]); }
            v[i] = v[i] * DN_ALPHA + *(const f32x4*)(md + 5120 + k0) * f;
            s += v[i][0] + v[i][1] + v[i][2] + v[i][3];
        }
        const float mu = wave_sum(s, lane) * (1.0f / 1024.0f);
        float q = 0.f;
#pragma unroll
        for (int i = 0; i < 4; ++i) { v[i] = v[i] - mu; q += v[i][0] * v[i][0] + v[i][1] * v[i][1] + v[i][2] * v[i][2] + v[i][3] * v[i][3]; }
        const float rstd = rsqrtf(wave_sum(q, lane) * (1.0f / 1024.0f) + NORM_EPS);
#pragma unroll
        for (int i = 0; i < 4; ++i) {
            const int k0 = (lane + 64 * i) * 4;
            const f32x4 x2 = v[i] * rstd * *(const f32x4*)(lg_ + k0) + *(const f32x4*)(lb_ + k0);
            if (last) { *(f32x4*)(a.out + ((size_t)(b * SEQ + j - CTXL)) * 1024 + k0) = x2; }
            else {
                *(f32x4*)(rr + k0) = x2;
                const float* mn = modn + (size_t)mi * 6144;
                const f32x4 h = x2 * (*(const f32x4*)(mn + 1024 + k0) + 1.0f) + *(const f32x4*)(mn + k0);
                u32x2 o = {pk_bf16(h[0], h[1]), pk_bf16(h[2], h[3])};
                *(u32x2*)(HB + (size_t)R * 1024 + k0) = o;
            }
        }
    }
#undef LN2_SLOTS
#undef LN2_ROWS
}

constexpr int KROW = 208, VROW = 136, KBUF = 64 * KROW, VBUF = 64 * VROW, KVBUF = KBUF + VBUF;

template <int MODE> __device__ __forceinline__ f32x16 att_mma(const bf16x8 a_, const bf16x8 b_, f32x16 c_) {
    if (MODE == 2) { c_[0] += __builtin_bit_cast(f32x4, a_)[0] + __builtin_bit_cast(f32x4, b_)[1]; return c_; }
    return __builtin_amdgcn_mfma_f32_32x32x16_bf16(a_, b_, c_, 0, 0, 0);
}
#define ATT_MMA(a_, b_, c_, x_, y_, z_) att_mma<MODE>(a_, b_, c_)
template <int MODE>
__device__ __forceinline__ void attn_qk(const LAS unsigned char* kb_, const bf16x8 (&qf)[6], f32x16 (&st)[2], const int ql, const int hf) {
#define ATT_KF(kb, s) (*(const LAS bf16x8*)(kb_ + ((kb) * 32 + ql) * KROW + (s) * 32 + hf * 16))
    bf16x8 ka[4], kc[4], ke[4];
#pragma unroll
    for (int s = 0; s < 2; ++s) { ka[2 * s] = ATT_KF(0, s); ka[2 * s + 1] = ATT_KF(1, s); }
#pragma unroll
    for (int s = 2; s < 4; ++s) { kc[2 * (s - 2)] = ATT_KF(0, s); kc[2 * (s - 2) + 1] = ATT_KF(1, s); }
    __builtin_amdgcn_sched_barrier(0);
#pragma unroll
    for (int i = 0; i < 16; ++i) { st[0][i] = 0.f; st[1][i] = 0.f; }
#pragma unroll
    for (int s = 0; s < 2; ++s) { st[0] = ATT_MMA(ka[2 * s], qf[s], st[0], 0, 0, 0); st[1] = ATT_MMA(ka[2 * s + 1], qf[s], st[1], 0, 0, 0); }
    __builtin_amdgcn_sched_barrier(0);
#pragma unroll
    for (int s = 4; s < 6; ++s) { ke[2 * (s - 4)] = ATT_KF(0, s); ke[2 * (s - 4) + 1] = ATT_KF(1, s); }
    __builtin_amdgcn_sched_barrier(0);
#pragma unroll
    for (int s = 2; s < 4; ++s) { st[0] = ATT_MMA(kc[2 * (s - 2)], qf[s], st[0], 0, 0, 0); st[1] = ATT_MMA(kc[2 * (s - 2) + 1], qf[s], st[1], 0, 0, 0); }
#pragma unroll
    for (int s = 4; s < 6; ++s) { st[0] = ATT_MMA(ke[2 * (s - 4)], qf[s], st[0], 0, 0, 0); st[1] = ATT_MMA(ke[2 * (s - 4) + 1], qf[s], st[1], 0, 0, 0); }
#undef ATT_KF
}
template <int MODE>
__device__ __forceinline__ void attn_pv(const LAS unsigned char* vb_, f32x16 (&st)[2], f32x16 (&ot)[2], float& mrun, float& lsum, const int ql, const int hf, const int lane) {
    if (MODE != 1) {
    float mx = max3f(st[0][0], st[1][0], st[0][1]), my = max3f(st[1][1], st[0][2], st[1][2]);
#pragma unroll
    for (int i = 3; i < 15; i += 2) { mx = max3f(mx, st[0][i], st[1][i]); my = max3f(my, st[0][i + 1], st[1][i + 1]); }
    mx = max3f(mx, st[0][15], st[1][15]); mx = max3f(mx, my, my);
    if (__builtin_amdgcn_ballot_w64(mx > mrun + 8.0f) != 0ull) {
        mx = fmaxf(mx, shx32(mx, lane));
        const float mnew = (mx > mrun + 8.0f) ? mx : mrun;
        const float alpha = fexp2(mrun - mnew);
        mrun = mnew; lsum *= alpha;
#pragma unroll
        for (int i = 0; i < 16; ++i) { ot[0][i] *= alpha; ot[1][i] *= alpha; }
    }
    float ps = 0.f;
#pragma unroll
    for (int kb = 0; kb < 2; ++kb)
#pragma unroll
        for (int i = 0; i < 16; ++i) { const float p = fexp2(st[kb][i] - mrun); st[kb][i] = p; ps += p; }
    lsum += ps;
    } else lsum += st[0][0];
#pragma unroll
    for (int kb = 0; kb < 2; ++kb)
#pragma unroll
        for (int sI = 0; sI < 2; ++sI) {
            u32x4 pw = {pk_bf16(st[kb][8 * sI + 0], st[kb][8 * sI + 1]), pk_bf16(st[kb][8 * sI + 2], st[kb][8 * sI + 3]),
                        pk_bf16(st[kb][8 * sI + 4], st[kb][8 * sI + 5]), pk_bf16(st[kb][8 * sI + 6], st[kb][8 * sI + 7])};
            const bf16x8 pf = __builtin_bit_cast(bf16x8, pw);
#pragma unroll
            for (int db = 0; db < 2; ++db) {
                const LAS unsigned char* vp = vb_ + (db * 32 + ql) * VROW + (kb * 32 + 16 * sI + 4 * hf) * 2;
                const u32x2 v0 = *(const LAS u32x2*)vp, v1 = *(const LAS u32x2*)(vp + 16);
                u32x4 vw = {v0[0], v0[1], v1[0], v1[1]};
                ot[db] = att_mma<MODE>(__builtin_bit_cast(bf16x8, vw), pf, ot[db]);
            }
        }
}

template <int MODE>
__device__ __forceinline__ void attn_phase(const Args& a, bool do_ctx, LAS unsigned char* lds, const int wid_s) {
    const int tid = mk_tid(wid_s);
    const int lane = tid & 63, wid = wid_s, ql = lane & 31, hf = lane >> 5, G = gridDim.x;
    const bf16_t* Q = (const bf16_t*)(a.ws + WS_Q); const bf16_t* KN = (const bf16_t*)(a.ws + WS_KN); const bf16_t* KR = (const bf16_t*)(a.ws + WS_KR);
    const bf16_t* VT = (const bf16_t*)(a.ws + WS_VT); bf16_t* AC = (bf16_t*)(a.ws + WS_AC);
    const int nitems = 1024 + (do_ctx ? 32 : 0);
    LAS unsigned char* const ldsv = lds + 2 * KBUF;
    for (int it = 0;; ++it) {
        const long L = (long)it * G + blockIdx.x; if (L >= nitems) break;
        int b, h, qt, nkt;
        if (L < 1024) { const int x = (int)(L % 8), q = (int)((L / 8) % 32), bh = (int)(L / 256) * 8 + x; b = bh >> 3; h = bh & 7; qt = q + 1; nkt = RPB / 64; }
        else { const int bh = (int)(L - 1024); b = bh >> 3; h = bh & 7; qt = 0; nkt = CTXL / 64; }
        const int rowbase = b * RPB;
        const int qrow = rowbase + qt * 256 + wid * 32 + ql;
        bf16x8 qf[6];
#pragma unroll
        for (int s = 0; s < 6; ++s) qf[s] = *(const bf16x8*)(Q + (size_t)qrow * 768 + h * 96 + s * 16 + hf * 8);
        const bf16_t* gkn = KN + ((size_t)(rowbase + (tid >> 3))) * 512 + h * 64 + (tid & 7) * 8;
        const bf16_t* gkr = KR + ((size_t)(rowbase + ((tid & 255) >> 2))) * 32 + (tid & 3) * 8;
        const bf16_t* gvt = VT + ((size_t)((b * NH + h) * 64 + (tid >> 3))) * RPB + (tid & 7) * 8;
        const unsigned skn = (unsigned)((tid >> 3) * KROW + (tid & 7) * 16);
        const unsigned skr = (unsigned)(((tid & 255) >> 2) * KROW + 128 + (tid & 3) * 16);
        const unsigned svt = (unsigned)((tid >> 3) * VROW + (tid & 7) * 16);
#define ATT_LOADK(rk, rr, kt_) do { if (MODE == 3 && (kt_) > 1) break; rk = *(const u32x4*)(gkn + (size_t)(kt_) * 64 * 512); rr = *(const u32x4*)(gkr + (size_t)(kt_) * 64 * 32); } while (0)
#define ATT_LOADV(rv, kt_) do { if (MODE == 3 && (kt_) > 1) break; rv = *(const u32x4*)(gvt + (size_t)(kt_) * 64); } while (0)
#define ATT_WRITEK(rk, rr, buf) do { LAS unsigned char* nb_ = lds + (buf) * KBUF; *(LAS u32x4*)(nb_ + skn) = rk; if (tid < 256) *(LAS u32x4*)(nb_ + skr) = rr; } while (0)
#define ATT_WRITEV(rv, buf) do { LAS u32x2* p_ = (LAS u32x2*)(ldsv + (buf) * VBUF + svt); u32x2 lo_ = {rv[0], rv[1]}, hi_ = {rv[2], rv[3]}; p_[0] = lo_; p_[1] = hi_; } while (0)
        u32x4 kK, kR, vV;
        ATT_LOADK(kK, kR, 0); ATT_LOADV(vV, 0);
        ATT_WRITEK(kK, kR, 0); ATT_WRITEV(vV, 0);
        ATT_LOADK(kK, kR, 1);
        ATT_WRITEK(kK, kR, 1);
        __syncthreads();
        f32x16 ot[2], sa[2], sb[2];
#pragma unroll
        for (int i = 0; i < 16; ++i) { ot[0][i] = 0.f; ot[1][i] = 0.f; }
        float mrun = -3.0e38f, lsum = 0.f;
        attn_qk<MODE>(lds, qf, sa, ql, hf);
        __syncthreads();
        for (int t = 0; t < nkt; t += 2) {
            if (t + 2 < nkt) ATT_LOADK(kK, kR, t + 2);
            ATT_LOADV(vV, t + 1);
            attn_qk<MODE>(lds + KBUF, qf, sb, ql, hf);
            __builtin_amdgcn_sched_barrier(0);
            attn_pv<MODE>(ldsv, sa, ot, mrun, lsum, ql, hf, lane);
            if (t + 2 < nkt) ATT_WRITEK(kK, kR, 0);
            ATT_WRITEV(vV, 1);
            __syncthreads();
            if (t + 3 < nkt) ATT_LOADK(kK, kR, t + 3);
            if (t + 2 < nkt) ATT_LOADV(vV, t + 2);
            if (t + 2 < nkt) attn_qk<MODE>(lds, qf, sa, ql, hf);
            __builtin_amdgcn_sched_barrier(0);
            attn_pv<MODE>(ldsv + VBUF, sb, ot, mrun, lsum, ql, hf, lane);
            if (t + 3 < nkt) ATT_WRITEK(kK, kR, 1);
            if (t + 2 < nkt) ATT_WRITEV(vV, 0);
            __syncthreads();
        }
#undef ATT_LOADK
#undef ATT_LOADV
#undef ATT_WRITEK
#undef ATT_WRITEV
        const float ltot = lsum + shx32(lsum, lane);
        const float inv = 1.0f / ltot;
        bf16_t* orow = AC + (size_t)qrow * 1024 + h * 64;
#pragma unroll
        for (int db = 0; db < 2; ++db)
#pragma unroll
            for (int g = 0; g < 4; ++g) {
                u32x2 o = {pk_bf16(ot[db][4 * g + 0] * inv, ot[db][4 * g + 1] * inv), pk_bf16(ot[db][4 * g + 2] * inv, ot[db][4 * g + 3] * inv)};
                if (MODE == 0 || (o[0] == 0x12345678u && o[1] == 0x9abcdef1u)) *(u32x2*)(orow + db * 32 + 8 * g + 4 * hf) = o;
            }
    }
}

__global__ void __launch_bounds__(NTHREADS, 2) mk_fwd(Args a) {
    extern __shared__ __attribute__((aligned(16))) unsigned char lds[];
    cg::grid_group grid = cg::this_grid();
    LAS unsigned char* ldsl = (LAS unsigned char*)lds;
    const int G = gridDim.x, bid = blockIdx.x;
    const int wid_s = __builtin_amdgcn_readfirstlane((int)(threadIdx.x >> 6));
    unsigned char* ws = a.ws;
    unsigned* gbar = (unsigned*)(ws + WS_CTL) + 128; unsigned gep = 0;

    REP(2) if (PH & 1) p0_phase(a, lds, wid_s);
    __threadfence();
    grid.sync();
    if (PH & 2) p1_phase(a, wid_s);
    gsync(gbar, ++gep, wid_s);

    for (int l = 0; l < DEPTH; ++l) {
        if (DUP & 128) { for (int q_ = 0; q_ < 20; ++q_) gsync(gbar, ++gep, wid_s); }
        REP(3) if (PH & 4) {
            pg8::SchedDense S{(const char*)(ws + WS_HB), (size_t)256 * 1024 * 2, (const char*)(ws + WS_WTIN) + (size_t)l * INWP * 1024 * 2, (size_t)256 * 1024 * 2, MR / 256, INWP / 256, G, bid, 0};
            EpiInproj E{(bf16_t*)(ws + WS_P), a.in[7] + (size_t)l * INW};
            pg8::gemm_phase(ldsl, 1024, 1024, S, E, wid_s);
        }
        if (DUP & 2048) {
            pg8::SchedDense S{(const char*)(ws + WS_HB), (size_t)256 * 1024 * 2, (const char*)(ws + WS_WTIN) + (size_t)l * INWP * 1024 * 2, (size_t)256 * 1024 * 2, MR / 256, INWP / 256, G, bid, 0};
            EpiNone E{(float*)(ws + WS_GWS)};
            pg8::gemm_phase(ldsl, 1024, 1024, S, E, wid_s);
        }
        if (DUP & 4096) {
            pg8::SchedDense S{(const char*)(ws + WS_HB), (size_t)256 * 1024 * 2, (const char*)(ws + WS_WTIN) + (size_t)l * INWP * 1024 * 2, (size_t)256 * 1024 * 2, MR / 256, INWP / 256, G, bid, 2};
            EpiNone E{(float*)(ws + WS_GWS)};
            pg8::gemm_phase(ldsl, 1024, 1024, S, E, wid_s);
        }
        gsync(gbar, ++gep, wid_s);
        REP(6) if (PH & 8) rowa_phase(a, l, wid_s);
        gsync(gbar, ++gep, wid_s);
        if (PH & 16) {
            const bool lastl = (l == DEPTH - 1);
            pg8::SchedQKV S{(const char*)(ws + WS_P), (const char*)(ws + WS_WTUQ) + (size_t)l * 768 * 256 * 2, (const char*)(ws + WS_P) + OFF_KV * 2, (const char*)(ws + WS_WTUKV) + (size_t)l * 1024 * 256 * 2,
                            (size_t)256 * INWP * 2, (size_t)256 * 256 * 2, lastl ? 128 : MR / 256, lastl ? 1 : 0, G, bid};
            EpiQKV E{EpiQ{(bf16_t*)(ws + WS_Q), (const float*)(ws + WS_RSQ), (const float2*)(ws + WS_ROPE)}, EpiKV{(bf16_t*)(ws + WS_KN), (bf16_t*)(ws + WS_VT), (const float*)(ws + WS_RSKV)}};
            pg8::gemm_phase(ldsl, 256, INWP, S, E, wid_s);
        }
        gsync(gbar, ++gep, wid_s);
        if (PH & 64) attn_phase<0>(a, l < DEPTH - 1, ldsl, wid_s);
        if (DUP & 1) attn_phase<AMODE>(a, l < DEPTH - 1, ldsl, wid_s);
        gsync(gbar, ++gep, wid_s);
        REP(5) {
        if (PH & 128) {
            pg8::SchedDense S{(const char*)(ws + WS_AC), (size_t)256 * 1024 * 2, (const char*)(ws + WS_WTOAB) + (size_t)l * 1024 * 1024 * 2, (size_t)256 * 512 * 2, (l == DEPTH - 1) ? 128 : MR / 256, 4, G, bid, (l == DEPTH - 1) ? 1 : 0};
            EpiMergeA E{(bf16_t*)(ws + WS_MG), (const bf16_t*)(ws + WS_P)};
            pg8::gemm_phase(ldsl, 512, 1024, S, E, wid_s);
        }
        if (PH & 128) {
            pg8::SchedDense S{(const char*)(ws + WS_AC) + 512 * 2, (size_t)256 * 1024 * 2, (const char*)(ws + WS_WTOAB) + (size_t)l * 1024 * 1024 * 2 + (size_t)1024 * 512 * 2, (size_t)256 * 512 * 2, (l == DEPTH - 1) ? 128 : MR / 256, 4, G, bid, (l == DEPTH - 1) ? 1 : 0};
            EpiMergeB E{(bf16_t*)(ws + WS_MG), (const bf16_t*)(ws + WS_P)};
            pg8::gemm_phase(ldsl, 512, 1024, S, E, wid_s);
        }
        }
        gsync(gbar, ++gep, wid_s);
        for (int rep_ = 0; rep_ <= (((DUP >> 8) & 1) && l == 0 ? 1 : 0); ++rep_) if (PH & 256) {
            pg8::SchedDense S{(const char*)(ws + WS_MG), (size_t)256 * 1024 * 2, (const char*)(ws + WS_WTO) + (size_t)l * 1024 * 1024 * 2, (size_t)256 * 1024 * 2, (l == DEPTH - 1) ? 128 : MR / 256, 4, G, bid, (l == DEPTH - 1) ? 1 : 0};
            EpiOut E{(float*)(ws + WS_RES), a.in[0], a.in[2], (const float*)(ws + WS_MOD) + (size_t)l * 5 * 6144, l};
            pg8::gemm_phase(ldsl, 1024, 1024, S, E, wid_s);
        }
        gsync(gbar, ++gep, wid_s);
        if (PH & 512) ln1_router_phase(a, l, lds, wid_s);
        gsync(gbar, ++gep, wid_s);
        REP(6) if (PH & 1024) gather_phase(a, l, lds, wid_s);
        gsync(gbar, ++gep, wid_s);
        REP(1) if (PH & 2048) {
            moe_prefix(a, l, lds, wid_s);
            const LAS int* ts = (const LAS int*)(ldsl + MISC_OFF);
            const int TM = ts[32];
            pg8::SchedMoe S{(const char*)(ws + WS_HB), (size_t)0, (const char*)(ws + WS_WTGU) + (size_t)l * NEXP * 2048 * 1024 * 2, (size_t)2048 * 1024 * 2, (size_t)256 * 1024 * 2, TM, 8, G, bid, ts};
            EpiGU E{(bf16_t*)(ws + WS_ACT), a.in[25] + (size_t)l * NEXP * 2048};
            {
                const int tid = mk_tid(wid_s); const int* RO = (const int*)(ws + WS_ROWOFF); LAS int* tab = (LAS int*)(ldsl + GTAB_OFF);
                pg8::Unit uu;
                for (int i = 0; i < 27 && S.next(i, uu); ++i) if (tid < 256) tab[i * 256 + tid] = RO[uu.pm * 256 + tid];
                __syncthreads();
            }
            pg8::gemm_phase<EpiGU, pg8::SchedMoe, true>(ldsl, 1024, 1024, S, E, wid_s, (const LAS int*)(ldsl + GTAB_OFF));
        }
        gsync(gbar, ++gep, wid_s);
        REP(1) if (PH & 4096) {
            const LAS int* ts = (const LAS int*)(ldsl + MISC_OFF);
            const int TM = ts[32];
            pg8::SchedMoe S{(const char*)(ws + WS_ACT), (size_t)256 * 1024 * 2, (const char*)(ws + WS_WTDN) + (size_t)l * NEXP * 1024 * 1024 * 2, (size_t)1024 * 1024 * 2, (size_t)256 * 1024 * 2, TM, 4, G, bid, ts};
            EpiDown E{(bf16_t*)(ws + WS_AS), a.in[27] + (size_t)l * NEXP * 1024, (const float*)(ws + WS_GWS)};
            pg8::gemm_phase(ldsl, 1024, 1024, S, E, wid_s);
        }
        gsync(gbar, ++gep, wid_s);
        for (int rep_ = 0; rep_ <= (((DUP >> 9) & 1) && l == DEPTH - 1 ? 1 : 0); ++rep_) if (PH & 8192) ln2_phase(a, l, wid_s);
        if (l + 1 < DEPTH) gsync(gbar, ++gep, wid_s);
    }
}

extern "C" void kernel_launch(void* const* d_in, const int* in_sizes, int n_in, void* d_out, int out_size, void* d_ws, size_t ws_size, hipStream_t stream) {
    static int grid = 0;
    if (grid == 0) {
        int dev = 0, cus = 0, per_cu = 0;
        if (hipGetDevice(&dev) != hipSuccess || hipDeviceGetAttribute(&cus, hipDeviceAttributeMultiprocessorCount, dev) != hipSuccess) { fprintf(stderr, "kernel_launch: device query failed\n"); grid = -1; return; }
        if (n_in != 28 || ws_size < WS_END) { fprintf(stderr, "kernel_launch: need 28 inputs and %zu B workspace; got %d, %zu\n", (size_t)WS_END, n_in, ws_size); grid = -1; return; }
        if (hipFuncSetAttribute((const void*)mk_fwd, hipFuncAttributeMaxDynamicSharedMemorySize, LDS_BYTES) != hipSuccess) { fprintf(stderr, "kernel_launch: hipFuncSetAttribute failed\n"); grid = -1; return; }
        if (hipOccupancyMaxActiveBlocksPerMultiprocessor(&per_cu, (const void*)mk_fwd, NTHREADS, LDS_BYTES) != hipSuccess || per_cu < 1) { fprintf(stderr, "kernel_launch: occupancy query says %d\n", per_cu); per_cu = 1; }
        (void)hipGetLastError();
        grid = cus;
        if (grid > 256) grid = 256;
        grid &= ~7;
    }
    if (grid <= 0) return;
    Args a{};
    for (int i = 0; i < 28; ++i) a.in[i] = (const float*)d_in[i];
    a.out = (float*)d_out; a.ws = (unsigned char*)d_ws;
    void* args[] = {&a};
    hipError_t e = hipLaunchCooperativeKernel((const void*)mk_fwd, dim3(grid), dim3(NTHREADS), args, LDS_BYTES, stream);
    if (e != hipSuccess) fprintf(stderr, "kernel_launch: cooperative launch failed: %s (grid %d)\n", hipGetErrorString(e), grid);
}
```

```cpp
#include <hip/hip_runtime.h>
#include <hip/hip_cooperative_groups.h>
#include <cstdio>
namespace cg = cooperative_groups;

#define LAS __attribute__((address_space(3)))
typedef unsigned short bf16_t;
typedef short bf16x8 __attribute__((ext_vector_type(8)));
typedef short bf16x4 __attribute__((ext_vector_type(4)));
typedef float f32x4 __attribute__((ext_vector_type(4)));
typedef float f32x16 __attribute__((ext_vector_type(16)));
typedef float f32x8 __attribute__((ext_vector_type(8)));
typedef float f32x2 __attribute__((ext_vector_type(2)));
typedef unsigned u32x4 __attribute__((ext_vector_type(4)));
typedef unsigned u32x2 __attribute__((ext_vector_type(2)));

constexpr int D = 1024, NBATCH = 4, SEQ = 8192, CTXL = 256, RPB = SEQ + CTXL, MR = NBATCH * RPB;
constexpr int DEPTH = 2, NH = 8, INW = 4000, INWP = 4096, NEXP = 32;
constexpr int OFF_KV = 256, OFF_KR = 384, OFF_CX = 416, OFF_CB = 928, OFF_CC = 1440, OFF_GA = 1952, OFF_GB = 2976;
constexpr float NORM_EPS = 1e-6f, DN_ALPHA = 1.41421356237f, SW_LIMIT = 7.0f, SW_ALPHA = 1.702f;
constexpr float QSCALE = 0.10206207261596575f * 1.4426950408889634f;
constexpr int SLOT_CAP = 143360;
constexpr int NTHREADS = 512;
constexpr int LDS_BYTES = 156 * 1024, MISC_OFF = 128 * 1024, GTAB_OFF = MISC_OFF + 1024;

constexpr size_t WS_CTL = 0;
constexpr size_t WS_MOD = 4096;
constexpr size_t WS_ROPE = WS_MOD + (size_t)DEPTH * 5 * 6144 * 4;
constexpr size_t WS_RSQ = WS_ROPE + (size_t)SEQ * 16 * 8;
constexpr size_t WS_RSKV = WS_RSQ + (size_t)MR * 4;
constexpr size_t WS_RE = WS_RSKV + (size_t)MR * 4;
constexpr size_t WS_RPOS = WS_RE + (size_t)MR * 16;
constexpr size_t WS_RG = WS_RPOS + (size_t)MR * 16;
constexpr size_t WS_SLOTOF = WS_RG + (size_t)MR * 16;
constexpr size_t WS_GWS = WS_SLOTOF + (size_t)MR * 16;
constexpr size_t WS_ROWOFF = WS_GWS + (size_t)SLOT_CAP * 4;
constexpr size_t WS_WTIN = WS_ROWOFF + (size_t)SLOT_CAP * 4;
constexpr size_t WS_WTUQ = WS_WTIN + (size_t)DEPTH * INWP * 1024 * 2;
constexpr size_t WS_WTUKV = WS_WTUQ + (size_t)DEPTH * 768 * 256 * 2;
constexpr size_t WS_WTOAB = WS_WTUKV + (size_t)DEPTH * 1024 * 256 * 2;
constexpr size_t WS_WTO = WS_WTOAB + (size_t)DEPTH * 1024 * 1024 * 2;
constexpr size_t WS_WTGU = WS_WTO + (size_t)DEPTH * 1024 * 1024 * 2;
constexpr size_t WS_WTDN = WS_WTGU + (size_t)DEPTH * NEXP * 2048 * 1024 * 2;
constexpr size_t WS_HB = WS_WTDN + (size_t)DEPTH * NEXP * 1024 * 1024 * 2;
constexpr size_t WS_P = WS_HB + (size_t)MR * 1024 * 2;
constexpr size_t WS_Q = WS_P + (size_t)MR * INWP * 2;
constexpr size_t WS_KN = WS_Q + (size_t)MR * 768 * 2;
constexpr size_t WS_KR = WS_KN + (size_t)MR * 512 * 2;
constexpr size_t WS_VT = WS_KR + (size_t)MR * 32 * 2;
constexpr size_t WS_AC = WS_VT + (size_t)MR * 512 * 2;
constexpr size_t WS_MG = WS_AC + (size_t)MR * 1024 * 2;
constexpr size_t WS_RES = WS_MG + (size_t)MR * 1024 * 2;
constexpr size_t WS_AS = WS_RES + (size_t)MR * 1024 * 4;
constexpr size_t WS_ACT = WS_AS + (size_t)SLOT_CAP * 1024 * 2;
constexpr size_t WS_END = WS_ACT + (size_t)SLOT_CAP * 1024 * 2;

#ifndef PH
#define PH 0xffff
#endif
#ifndef DUP
#define DUP 0
#endif
#ifndef AMODE
#define AMODE 0
#endif
#define REP(k) for (int rep_ = 0; rep_ <= ((DUP >> (k)) & 1); ++rep_)
struct Args { const float* in[28]; float* out; unsigned char* ws; };

__device__ __forceinline__ int lane_id() { int l; asm volatile("v_mbcnt_lo_u32_b32 %0, -1, 0\n\tv_mbcnt_hi_u32_b32 %0, -1, %0" : "=v"(l)); return l; }
__device__ __forceinline__ int mk_tid(int wid_s) { return wid_s * 64 + lane_id(); }
template <int M> __device__ __forceinline__ float swz(float v) { return __int_as_float(__builtin_amdgcn_ds_swizzle(__float_as_int(v), (M << 10) | 0x1f)); }
__device__ __forceinline__ float shx32(float v, int lane) { return __int_as_float(__builtin_amdgcn_ds_bpermute((lane ^ 32) << 2, __float_as_int(v))); }
__device__ __forceinline__ void gsync(unsigned* bar, unsigned epoch, int wid_s) {
    asm volatile("s_waitcnt vmcnt(0)" ::: "memory");
    __syncthreads();
    if (wid_s == 0) {
        if (lane_id() == 0) {
            __builtin_amdgcn_fence(__ATOMIC_RELEASE, "agent");
            const unsigned per = gridDim.x >> 3;
            const unsigned old = __hip_atomic_fetch_add(bar + 32u * (1u + (blockIdx.x & 7u)), 1u, __ATOMIC_RELAXED, __HIP_MEMORY_SCOPE_AGENT);
            if (old + 1u == epoch * per) __hip_atomic_fetch_add(bar, 1u, __ATOMIC_RELAXED, __HIP_MEMORY_SCOPE_AGENT);
            while (__hip_atomic_load(bar, __ATOMIC_RELAXED, __HIP_MEMORY_SCOPE_AGENT) < epoch * 8u) __builtin_amdgcn_s_sleep(1);
            __builtin_amdgcn_fence(__ATOMIC_ACQUIRE, "agent");
        }
    }
    __syncthreads();
}
__device__ __forceinline__ unsigned pk_bf16(float lo, float hi) { unsigned r; asm("v_cvt_pk_bf16_f32 %0, %1, %2" : "=v"(r) : "v"(lo), "v"(hi)); return r; }
__device__ __forceinline__ float bf_lo(unsigned u) { return __uint_as_float(u << 16); }
__device__ __forceinline__ float bf_hi(unsigned u) { return __uint_as_float(u & 0xffff0000u); }
__device__ __forceinline__ float bf2f(bf16_t b) { return __uint_as_float(((unsigned)b) << 16); }
__device__ __forceinline__ float fexp2(float x) { return __builtin_amdgcn_exp2f(x); }
__device__ __forceinline__ float frcp(float x) { return __builtin_amdgcn_rcpf(x); }
__device__ __forceinline__ float sigmoidf_(float x) { return frcp(1.0f + fexp2(-1.4426950408889634f * x)); }
__device__ __forceinline__ float max3f(float a, float b, float c) { float d; asm("v_max3_f32 %0, %1, %2, %3" : "=v"(d) : "v"(a), "v"(b), "v"(c)); return d; }
__device__ __forceinline__ float wave_sum(float v, int lane) {
    v += shx32(v, lane); v += swz<16>(v); v += swz<8>(v); v += swz<4>(v); v += swz<2>(v); v += swz<1>(v);
    return v;
}

namespace pg8 {
constexpr int BM = 256, BK = 64, HALF = 128, HTB = HALF * BK * 2;
__device__ __forceinline__ int lds_byte(int r, int c) { const int st = (r >> 4) * 2 + (c >> 5), rr = r & 15, cc = c & 31, ob = rr * 64 + cc * 2; return st * 1024 + (ob ^ (((ob >> 9) & 1) << 5)); }
__device__ __forceinline__ void stage_rc(int b, int& R, int& C) { const int st = b / 1024, sb = b % 1024, swz = sb ^ (((sb >> 9) & 1) << 5); R = (st >> 1) * 16 + swz / 64; C = (st & 1) * 32 + (swz % 64) / 2; }
__device__ __forceinline__ int perm32(int rho) { const int n = rho >> 4, i = rho & 15; return 8 * (i >> 2) + 4 * n + (i & 3); }

struct Unit { const char* A; const char* B; int pm, pn, e; };

__device__ __forceinline__ bool unit_coords(unsigned L, int nM, int nN, int& pm, int& pn) {
    const unsigned total = (unsigned)nM * (unsigned)nN; if (L >= total) return false;
    const unsigned fullg = (unsigned)nM >> 3, full = fullg * 8u * (unsigned)nN;
    if (L < full) {
        const unsigned x = L & 7u, q = L >> 3;
        if (nN == 16 && (fullg & 7u) == 0u) {
            const unsigned blk = q >> 5, in = q & 31u;
            pn = (int)((blk & 1u) * 8u + (in & 7u)); pm = (int)(((blk >> 1) * 4u + (in >> 3)) * 8u + x);
        } else { const unsigned qd = q / (unsigned)nN; pn = (int)(q - qd * (unsigned)nN); pm = (int)(qd * 8u + x); }
    }
    else { const unsigned r = (unsigned)nM & 7u, Lp = L - full; const unsigned qd = Lp / r; pm = (int)(fullg * 8u + (Lp - qd * r)); pn = (int)qd; }
    return true;
}
struct SchedDense {
    const char* A; size_t a_tstep; const char* B; size_t b_tstep; int nM, nN, G, c, skipctx;
    __device__ __forceinline__ bool next(int i, Unit& u) const {
        int pm, pn; if (!unit_coords((unsigned)(i * G + c), nM, nN, pm, pn)) return false;
        if (skipctx == 1) pm += (pm >> 5) + 1;
        if (skipctx == 2) { pm = 0; pn = 0; }
        u.pm = pm; u.pn = pn; u.e = 0; u.A = A + (size_t)pm * a_tstep; u.B = B + (size_t)pn * b_tstep; return true;
    }
};
struct SchedQKV {
    const char* Aq; const char* Bq; const char* Akv; const char* Bkv; size_t a_tstep, b_tstep; int nMq, skipq, G, c;
    __device__ __forceinline__ bool next(int i, Unit& u) const {
        const unsigned L = (unsigned)(i * G + c), nQ = (unsigned)nMq * 3u;
        int pm, pn;
        if (L < nQ) { unit_coords(L, nMq, 3, pm, pn); if (skipq) pm += (pm >> 5) + 1; u.e = 0; u.A = Aq + (size_t)pm * a_tstep; u.B = Bq + (size_t)pn * b_tstep; }
        else { if (!unit_coords(L - nQ, MR / 256, 4, pm, pn)) return false; u.e = 1; u.A = Akv + (size_t)pm * a_tstep; u.B = Bkv + (size_t)pn * b_tstep; }
        u.pm = pm; u.pn = pn; return true;
    }
};
struct SchedMoe {
    const char* A; size_t a_tstep; const char* W; size_t w_estep, b_tstep; int nM, nN, G, c; const LAS int* tstart;
    __device__ __forceinline__ bool next(int i, Unit& u) const {
        int pm, pn; if (!unit_coords((unsigned)(i * G + c), nM, nN, pm, pn)) return false;
        { const int fullg = nM >> 3; if (pm < fullg * 8) pm = (pm & 7) * fullg + (pm >> 3); }
        int e = 0;
#pragma unroll 1
        for (int k = 16; k >= 1; k >>= 1) if (tstart[e + k] <= pm) e += k;
        u.pm = pm; u.pn = pn; u.e = e; u.A = A + (size_t)pm * a_tstep; u.B = W + (size_t)e * w_estep + (size_t)pn * b_tstep; return true;
    }
};

typedef f32x4 Acc[2][2][4][2];

template <class Epi, class Sched, bool GATHER = false>
__device__ __forceinline__ void gemm_phase(LAS unsigned char* lds, const int K, const int lda, const Sched& S, const Epi& E, const int wid_s, const LAS int* rowoff = nullptr) {
    const int tid = mk_tid(wid_s);
    const int wid = wid_s, lane = tid & 63, wr = wid >> 2, wc = wid & 3, fr = lane & 15, fq = lane >> 4;
    const int nt = K / BK;
    unsigned voffA[2], voffB[2];
#pragma unroll
    for (int i = 0; i < 2; ++i) { int R, C; stage_rc(tid * 16 + i * 8192, R, C); const int Rb = (R & ~31) + perm32(R & 31);
        voffA[i] = (unsigned)(R * lda + C) * 2u; voffB[i] = (unsigned)(Rb * K + C) * 2u; }
    const size_t kstep = (size_t)(BK * 2);
    const size_t hstepA = GATHER ? (size_t)0 : (size_t)HALF * lda * 2, hstepB = (size_t)HALF * K * 2;
    int gR[2], gC[2];
#pragma unroll
    for (int i = 0; i < 2; ++i) stage_rc(tid * 16 + i * 8192, gR[i], gC[i]);
    unsigned gcur[2][2], gnxt[2][2];
#define PG8_GLOAD(dst, pm_) do { _Pragma("unroll") for (int h_ = 0; h_ < 2; ++h_) _Pragma("unroll") for (int i_ = 0; i_ < 2; ++i_) dst[h_][i_] = (unsigned)rowoff[(pm_) * 256 + h_ * 128 + gR[i_]] + (unsigned)gC[i_] * 2u; } while (0)
    const unsigned ldsw = (unsigned)wid * 1024u;
    const int aoff = lds_byte(wr * 64 + fr, fq * 8), boff = lds_byte(wc * 32 + fr, fq * 8);
#define PG8_SA(b, h) (((b) * 2 + (h)) * HTB)
#define PG8_SB(b, h) ((4 + (b) * 2 + (h)) * HTB)
#define PG8_STAGE(bufoff, gbase, voff) do { const char* _gb = (const char*)(gbase); asm volatile("" : "+s"(_gb)); _Pragma("unroll") for (int _i = 0; _i < 2; ++_i) \
        __builtin_amdgcn_global_load_lds((const unsigned*)(_gb + (voff)[_i]), (LAS unsigned*)(lds + (bufoff) + ldsw + _i * 8192), 16, 0, 0); } while (0)
#define PG8_STAGEA(bufoff, gbase, h_, usenext) do { if (GATHER) { unsigned go_[2] = {(usenext) ? gnxt[h_][0] : gcur[h_][0], (usenext) ? gnxt[h_][1] : gcur[h_][1]}; PG8_STAGE(bufoff, gbase, go_); } else PG8_STAGE(bufoff, (gbase) + (h_) * hstepA, voffA); } while (0)
#define PG8_LDA(dst, b, h) do { _Pragma("unroll") for (int m = 0; m < 4; ++m) _Pragma("unroll") for (int k = 0; k < 2; ++k) dst[m][k] = *(const LAS bf16x8*)(lds + PG8_SA(b, h) + aoff + m * 2048 + k * 1024); } while (0)
#define PG8_LDB(dst, b, h) do { _Pragma("unroll") for (int n = 0; n < 2; ++n) _Pragma("unroll") for (int k = 0; k < 2; ++k) dst[n][k] = *(const LAS bf16x8*)(lds + PG8_SB(b, h) + boff + n * 2048 + k * 1024); } while (0)
#define PG8_MMA(ai, bj, At, Bt) do { __builtin_amdgcn_s_setprio(1); _Pragma("unroll") for (int m = 0; m < 4; ++m) _Pragma("unroll") for (int n = 0; n < 2; ++n) _Pragma("unroll") for (int k = 0; k < 2; ++k) \
        acc[ai][bj][m][n] = __builtin_amdgcn_mfma_f32_16x16x32_bf16(Bt[n][k], At[m][k], acc[ai][bj][m][n], 0, 0, 0); __builtin_amdgcn_s_setprio(0); } while (0)
#define PG8_WAIT_V(n) asm volatile("s_waitcnt vmcnt(" #n ")" ::: "memory")
#define PG8_WAIT_L(n) asm volatile("s_waitcnt lgkmcnt(" #n ")" ::: "memory")
#define PG8_BAR __builtin_amdgcn_s_barrier()
#define PG8_SCHED __builtin_amdgcn_sched_barrier(0)
    Unit cur, nxt; int ui = 0;
    if (!S.next(0, cur)) return;
    Acc acc;
#pragma unroll
    for (int a = 0; a < 2; ++a)
#pragma unroll
        for (int b = 0; b < 2; ++b)
#pragma unroll
            for (int m = 0; m < 4; ++m)
#pragma unroll
                for (int n = 0; n < 2; ++n) acc[a][b][m][n] = (f32x4){0.f, 0.f, 0.f, 0.f};
    bf16x8 At[4][2], B0[2][2], B1[2][2];
    const char* cA = cur.A; const char* cB = cur.B;
    if (GATHER) { PG8_GLOAD(gcur, 0); }
    PG8_STAGE(PG8_SB(0, 0), cB, voffB); PG8_STAGEA(PG8_SA(0, 0), cA, 0, false); PG8_STAGE(PG8_SB(0, 1), cB + hstepB, voffB); PG8_STAGEA(PG8_SA(0, 1), cA, 1, false);
    if (wr == 1) PG8_BAR;
    PG8_WAIT_V(4); PG8_BAR;
    PG8_STAGE(PG8_SB(1, 0), cB + kstep, voffB); PG8_STAGEA(PG8_SA(1, 0), cA + kstep, 0, false); PG8_STAGE(PG8_SB(1, 1), cB + hstepB + kstep, voffB);
    PG8_WAIT_V(6); PG8_BAR;
    for (;;) {
        const bool has_next = S.next(ui + 1, nxt);
        const char* nA = has_next ? nxt.A : cA; const char* nB = has_next ? nxt.B : cB;
        if (GATHER) { if (has_next) PG8_GLOAD(gnxt, ui + 1); else { _Pragma("unroll") for (int h_ = 0; h_ < 2; ++h_) _Pragma("unroll") for (int i_ = 0; i_ < 2; ++i_) gnxt[h_][i_] = gcur[h_][i_]; } }
#pragma unroll 1
        for (int t = 0; t < nt; t += 2) {
            const bool last = (t == nt - 2);
            const char* a1 = cA + (size_t)(t + 1) * kstep;
            const char* a2 = last ? nA : cA + (size_t)(t + 2) * kstep; const char* b2 = last ? nB : cB + (size_t)(t + 2) * kstep;
            const char* a3 = a2 + kstep; const char* b3 = b2 + kstep;
            PG8_LDB(B0, 0, 0); PG8_SCHED; PG8_LDA(At, 0, 0); PG8_STAGEA(PG8_SA(1, 1), a1, 1, false);
            PG8_WAIT_L(8); PG8_BAR; PG8_WAIT_L(0); PG8_MMA(0, 0, At, B0); PG8_BAR; PG8_SCHED;
            PG8_LDB(B1, 0, 1); PG8_STAGE(PG8_SB(0, 0), b2, voffB);
            PG8_BAR; PG8_WAIT_L(0); PG8_MMA(0, 1, At, B1); PG8_BAR;
            PG8_LDA(At, 0, 1); PG8_STAGEA(PG8_SA(0, 0), a2, 0, last);
            PG8_BAR; PG8_WAIT_L(0); PG8_MMA(1, 0, At, B0); PG8_BAR; PG8_SCHED;
            PG8_STAGE(PG8_SB(0, 1), b2 + hstepB, voffB);
            PG8_WAIT_V(6); PG8_BAR; PG8_MMA(1, 1, At, B1); PG8_BAR;
            PG8_LDB(B0, 1, 0); PG8_SCHED; PG8_LDA(At, 1, 0); PG8_STAGEA(PG8_SA(0, 1), a2, 1, last);
            PG8_WAIT_L(8); PG8_BAR; PG8_WAIT_L(0); PG8_MMA(0, 0, At, B0); PG8_BAR; PG8_SCHED;
            PG8_LDB(B1, 1, 1); PG8_STAGE(PG8_SB(1, 0), b3, voffB);
            PG8_BAR; PG8_WAIT_L(0); PG8_MMA(0, 1, At, B1); PG8_BAR;
            PG8_LDA(At, 1, 1); PG8_STAGEA(PG8_SA(1, 0), a3, 0, last);
            PG8_BAR; PG8_WAIT_L(0); PG8_MMA(1, 0, At, B0); PG8_BAR; PG8_SCHED;
            PG8_STAGE(PG8_SB(1, 1), b3 + hstepB, voffB);
            PG8_WAIT_V(6); PG8_BAR; PG8_MMA(1, 1, At, B1); PG8_BAR;
        }
        E(acc, cur, wr, wc, fr, fq);
        if (!has_next) break;
#pragma unroll
        for (int a = 0; a < 2; ++a)
#pragma unroll
            for (int b = 0; b < 2; ++b)
#pragma unroll
                for (int m = 0; m < 4; ++m)
#pragma unroll
                    for (int n = 0; n < 2; ++n) acc[a][b][m][n] = (f32x4){0.f, 0.f, 0.f, 0.f};
        cur = nxt; cA = nA; cB = nB; ++ui;
        if (GATHER) { _Pragma("unroll") for (int h_ = 0; h_ < 2; ++h_) _Pragma("unroll") for (int i_ = 0; i_ < 2; ++i_) gcur[h_][i_] = gnxt[h_][i_]; }
    }
    PG8_WAIT_V(0);
    if (wr == 0) PG8_BAR;
    PG8_BAR;
#undef PG8_SA
#undef PG8_SB
#undef PG8_STAGE
#undef PG8_LDA
#undef PG8_STAGEA
#undef PG8_GLOAD
#undef PG8_LDB
#undef PG8_MMA
#undef PG8_WAIT_V
#undef PG8_WAIT_L
#undef PG8_BAR
#undef PG8_SCHED
}
}
using pg8::Acc; using pg8::Unit;

#define EPI_ROW(u, ai, m) ((u).pm * 256 + (ai) * 128 + wr * 64 + (m) * 16 + fr)
#define EPI_COL(u, bj) ((u).pn * 256 + (bj) * 128 + wc * 32 + 8 * fq)

#define EPI_PIN(r) asm volatile("" : "+v"(r))
#define EPI_FOR_BJ _Pragma("unroll") for (int bj = 0; bj < 2; ++bj)
#define EPI_FOR_AM _Pragma("unroll") for (int ai = 0; ai < 2; ++ai) _Pragma("unroll") for (int m = 0; m < 4; ++m)
__device__ __forceinline__ u32x4 pack8(const f32x4 a, const f32x4 b) { u32x4 o = {pk_bf16(a[0], a[1]), pk_bf16(a[2], a[3]), pk_bf16(b[0], b[1]), pk_bf16(b[2], b[3])}; return o; }

struct EpiInproj {
    static constexpr bool MID = false;
    bf16_t* P; const float* bias;
    __device__ __forceinline__ void operator()(Acc& acc, const Unit& u, int wr, int wc, int fr, int fq) const {
        f32x4 b0[2], b1[2];
        EPI_FOR_BJ { const int c0 = EPI_COL(u, bj); b0[bj] = (f32x4){0.f, 0.f, 0.f, 0.f}; b1[bj] = b0[bj];
            if (c0 < INW) { b0[bj] = *(const f32x4*)(bias + c0); b1[bj] = *(const f32x4*)(bias + c0 + 4); } }
        EPI_FOR_BJ { const int c0 = EPI_COL(u, bj);
            EPI_FOR_AM { int r = EPI_ROW(u, ai, m); EPI_PIN(r);
                *(u32x4*)(P + (size_t)r * INWP + c0) = pack8(acc[ai][bj][m][0] + b0[bj], acc[ai][bj][m][1] + b1[bj]);
                __builtin_amdgcn_sched_barrier(0); } }
    }
};

struct EpiNone {
    static constexpr bool MID = false;
    float* dummy;
    __device__ __forceinline__ void operator()(Acc& acc, const Unit& u, int wr, int wc, int fr, int fq) const {
        float t = 0.f;
        EPI_FOR_BJ EPI_FOR_AM t += acc[ai][bj][m][0][0] + acc[ai][bj][m][1][3];
        if (t == 12345.678f) dummy[0] = t;
    }
};

struct EpiQ {
    static constexpr bool MID = false;
    bf16_t* Q; const float* rs; const float2* cs;
    __device__ __forceinline__ void operator()(Acc& acc, const Unit& u, int wr, int wc, int fr, int fq) const {
        const bool is_ctx = (u.pm % 33) == 0;
        float sc[2][4];
        EPI_FOR_AM { const int r = EPI_ROW(u, ai, m); sc[ai][m] = rs[r] * QSCALE; }
        EPI_FOR_BJ {
            const int grp = (u.pn * 256 + bj * 128 + wc * 32) >> 5;
            const bool rope = ((grp % 3) == 2) && !is_ctx;
            EPI_FOR_AM { int r = EPI_ROW(u, ai, m); EPI_PIN(r);
                acc[ai][bj][m][0] *= sc[ai][m]; acc[ai][bj][m][1] *= sc[ai][m];
                if (rope) {
                    const int t = (r % RPB) - CTXL;
                    const float2* c2 = cs + (size_t)t * 16 + (fq >> 1) * 8;
#pragma unroll
                    for (int e = 0; e < 8; ++e) {
                        const float v = acc[ai][bj][m][e >> 2][e & 3];
                        const float pv = swz<16>(v);
                        const float2 csv = c2[e];
                        acc[ai][bj][m][e >> 2][e & 3] = v * csv.x + ((fq & 1) ? pv : -pv) * csv.y;
                    }
                }
                __builtin_amdgcn_sched_barrier(0); } }
        EPI_FOR_BJ { const int c0 = EPI_COL(u, bj);
            EPI_FOR_AM { int r = EPI_ROW(u, ai, m); EPI_PIN(r);
                *(u32x4*)(Q + (size_t)r * 768 + c0) = pack8(acc[ai][bj][m][0], acc[ai][bj][m][1]);
                __builtin_amdgcn_sched_barrier(0); } }
    }
};

struct EpiKV {
    static constexpr bool MID = false;
    bf16_t* KN; bf16_t* VT; const float* rs;
    __device__ __forceinline__ void operator()(Acc& acc, const Unit& u, int wr, int wc, int fr, int fq) const {
        float sc[2][4];
        EPI_FOR_AM { const int r = EPI_ROW(u, ai, m); sc[ai][m] = rs[r]; }
        EPI_FOR_BJ { const int c0 = EPI_COL(u, bj);
            EPI_FOR_AM { int r = EPI_ROW(u, ai, m); EPI_PIN(r);
                const f32x4 v0 = acc[ai][bj][m][0] * sc[ai][m], v1 = acc[ai][bj][m][1] * sc[ai][m];
                if (u.pn < 2) *(u32x4*)(KN + (size_t)r * 512 + c0) = pack8(v0, v1);
                else {
                    const int da = c0 - 512, hh = da >> 6, d = da & 63, b = r / RPB, j = r % RPB;
                    bf16_t* base = VT + ((size_t)((b * NH + hh) * 64 + d)) * RPB + j;
                    const u32x4 pk = pack8(v0, v1);
#pragma unroll
                    for (int e = 0; e < 4; ++e) { base[(size_t)(2 * e) * RPB] = (bf16_t)(pk[e] & 0xffffu); base[(size_t)(2 * e + 1) * RPB] = (bf16_t)(pk[e] >> 16); }
                }
                __builtin_amdgcn_sched_barrier(0); } }
    }
};

struct EpiQKV {
    static constexpr bool MID = false;
    EpiQ q; EpiKV kv;
    __device__ __forceinline__ void operator()(Acc& acc, const Unit& u, int wr, int wc, int fr, int fq) const {
        if (u.e == 0) q(acc, u, wr, wc, fr, fq); else kv(acc, u, wr, wc, fr, fq);
    }
};

struct EpiMergeA {
    static constexpr bool MID = false;
    bf16_t* MG; const bf16_t* P;
    __device__ __forceinline__ void operator()(Acc& acc, const Unit& u, int wr, int wc, int fr, int fq) const {
        EPI_FOR_BJ { const int c0 = EPI_COL(u, bj);
            EPI_FOR_AM { int r = EPI_ROW(u, ai, m); EPI_PIN(r);
                const u32x4 ga = *(const u32x4*)(P + (size_t)r * INWP + OFF_GA + c0);
#pragma unroll
                for (int e = 0; e < 8; ++e) acc[ai][bj][m][e >> 2][e & 3] *= sigmoidf_((e & 1) ? bf_hi(ga[e >> 1]) : bf_lo(ga[e >> 1]));
                __builtin_amdgcn_sched_barrier(0); } }
        EPI_FOR_BJ { const int c0 = EPI_COL(u, bj);
            EPI_FOR_AM { int r = EPI_ROW(u, ai, m); EPI_PIN(r);
                *(u32x4*)(MG + (size_t)r * 1024 + c0) = pack8(acc[ai][bj][m][0], acc[ai][bj][m][1]);
                __builtin_amdgcn_sched_barrier(0); } }
    }
};
struct EpiMergeB {
    static constexpr bool MID = false;
    bf16_t* MG; const bf16_t* P;
    __device__ __forceinline__ void operator()(Acc& acc, const Unit& u, int wr, int wc, int fr, int fq) const {
        EPI_FOR_BJ { const int c0 = EPI_COL(u, bj);
            EPI_FOR_AM { int r = EPI_ROW(u, ai, m); EPI_PIN(r);
                const u32x4 gb = *(const u32x4*)(P + (size_t)r * INWP + OFF_GB + c0);
                const u32x4 mo = *(const u32x4*)(MG + (size_t)r * 1024 + c0);
#pragma unroll
                for (int e = 0; e < 8; ++e) {
                    const float g = sigmoidf_((e & 1) ? bf_hi(gb[e >> 1]) : bf_lo(gb[e >> 1])), o = (e & 1) ? bf_hi(mo[e >> 1]) : bf_lo(mo[e >> 1]);
                    acc[ai][bj][m][e >> 2][e & 3] = o + acc[ai][bj][m][e >> 2][e & 3] * g;
                }
                __builtin_amdgcn_sched_barrier(0); } }
        EPI_FOR_BJ { const int c0 = EPI_COL(u, bj);
            EPI_FOR_AM { int r = EPI_ROW(u, ai, m); EPI_PIN(r);
                *(u32x4*)(MG + (size_t)r * 1024 + c0) = pack8(acc[ai][bj][m][0], acc[ai][bj][m][1]);
                __builtin_amdgcn_sched_barrier(0); } }
    }
};

struct EpiOut {
    static constexpr bool MID = false;
    float* RES; const float* x_in; const float* ctx_in; const float* mod; int layer;
    __device__ __forceinline__ void operator()(Acc& acc, const Unit& u, int wr, int wc, int fr, int fq) const {
        const int b = u.pm / 33; const bool is_ctx = (u.pm % 33) == 0;
        const float* g1 = mod + (size_t)(is_ctx ? 4 : b) * 6144 + 2048;
        f32x4 g0[2], g4[2];
        EPI_FOR_BJ { const int c0 = EPI_COL(u, bj); g0[bj] = *(const f32x4*)(g1 + c0); g4[bj] = *(const f32x4*)(g1 + c0 + 4); }
        EPI_FOR_BJ { const int c0 = EPI_COL(u, bj);
            EPI_FOR_AM { int r = EPI_ROW(u, ai, m); EPI_PIN(r);
                const float* xr;
                if (layer == 0) { const int j = r % RPB; xr = is_ctx ? ctx_in + ((size_t)(b * CTXL + j)) * 1024 : x_in + ((size_t)(b * SEQ + j - CTXL)) * 1024; }
                else xr = RES + (size_t)r * 1024;
                const f32x4 x0 = *(const f32x4*)(xr + c0), x4 = *(const f32x4*)(xr + c0 + 4);
                acc[ai][bj][m][0] = x0 * DN_ALPHA + g0[bj] * acc[ai][bj][m][0];
                acc[ai][bj][m][1] = x4 * DN_ALPHA + g4[bj] * acc[ai][bj][m][1];
                __builtin_amdgcn_sched_barrier(0); }
            EPI_FOR_AM { int r = EPI_ROW(u, ai, m); EPI_PIN(r);
                *(f32x4*)(RES + (size_t)r * 1024 + c0) = acc[ai][bj][m][0];
                *(f32x4*)(RES + (size_t)r * 1024 + c0 + 4) = acc[ai][bj][m][1];
                __builtin_amdgcn_sched_barrier(0); } }
    }
};

struct EpiGU {
    static constexpr bool MID = false;
    bf16_t* ACT; const float* bgu;
    __device__ __forceinline__ void operator()(Acc& acc, const Unit& u, int wr, int wc, int fr, int fq) const {
        const int cj = u.pn * 128 + wc * 32 + 8 * fq;
        const float* bb = bgu + (size_t)u.e * 2048;
        const f32x4 bg0 = *(const f32x4*)(bb + cj), bg1 = *(const f32x4*)(bb + cj + 4), bu0 = *(const f32x4*)(bb + 1024 + cj), bu1 = *(const f32x4*)(bb + 1024 + cj + 4);
        EPI_FOR_AM { int r = EPI_ROW(u, ai, m); EPI_PIN(r);
            float v[8];
#pragma unroll
            for (int e = 0; e < 8; ++e) {
                const float gb = (e < 4) ? bg0[e & 3] : bg1[e & 3], ub = (e < 4) ? bu0[e & 3] : bu1[e & 3];
                const float gate = fminf(acc[ai][0][m][e >> 2][e & 3] + gb, SW_LIMIT);
                const float up = fminf(fmaxf(acc[ai][1][m][e >> 2][e & 3] + ub, -SW_LIMIT), SW_LIMIT);
                v[e] = (up + 1.0f) * gate * sigmoidf_(SW_ALPHA * gate);
            }
            u32x4 o = {pk_bf16(v[0], v[1]), pk_bf16(v[2], v[3]), pk_bf16(v[4], v[5]), pk_bf16(v[6], v[7])};
            *(u32x4*)(ACT + (size_t)r * 1024 + cj) = o;
            __builtin_amdgcn_sched_barrier(0); }
    }
};

struct EpiDown {
    static constexpr bool MID = false;
    bf16_t* YS; const float* bdn; const float* gws;
    __device__ __forceinline__ void operator()(Acc& acc, const Unit& u, int wr, int wc, int fr, int fq) const {
        const float* bb = bdn + (size_t)u.e * 1024;
        float g[2][4]; f32x4 b0[2], b1[2];
        EPI_FOR_AM { const int r = EPI_ROW(u, ai, m); g[ai][m] = gws[r]; }
        EPI_FOR_BJ { const int c0 = EPI_COL(u, bj); b0[bj] = *(const f32x4*)(bb + c0); b1[bj] = *(const f32x4*)(bb + c0 + 4); }
        EPI_FOR_BJ { const int c0 = EPI_COL(u, bj);
            EPI_FOR_AM { int r = EPI_ROW(u, ai, m); EPI_PIN(r);
                *(u32x4*)(YS + (size_t)r * 1024 + c0) = pack8((acc[ai][bj][m][0] + b0[bj]) * g[ai][m], (acc[ai][bj][m][1] + b1[bj]) * g[ai][m]);
                __builtin_amdgcn_sched_barrier(0); } }
    }
};

struct ConvJob { const float* src; int ldsrc, k0, n0, Kvalid, Nvalid; const float* kscale; bf16_t* dst; int lddst; };

__device__ __forceinline__ void conv_tile4(const ConvJob (&J)[4], float* T  , const int tid) {
    f32x4 v[8];
    const int n4 = (tid & 63) * 4, jt = n4 >> 6, nn0 = n4 & 63;
    const float* const src0 = J[0].src; const int ld0 = J[0].ldsrc, kb0 = J[0].k0 + (tid >> 6), nb0 = J[0].n0 + n4, kv0 = J[0].Kvalid;
    const bool nok = nb0 < J[0].Nvalid;
#pragma unroll
    for (int it = 0; it < 8; ++it) {
        f32x4 t = {0.f, 0.f, 0.f, 0.f};
        if (nok && kb0 + 8 * it < kv0) t = *(const f32x4*)(src0 + (size_t)(kb0 + 8 * it) * ld0 + nb0);
        v[it] = t;
    }
    if (J[0].kscale) {
        const float* const ks = J[0].kscale;
#pragma unroll
        for (int it = 0; it < 8; ++it) { float sc = 1.0f; if (kb0 + 8 * it < kv0) sc = ks[kb0 + 8 * it]; v[it] *= sc; }
    }
    float* const tp0 = T + jt * 4160 + (tid >> 6) * 65 + nn0;
#pragma unroll
    for (int it = 0; it < 8; ++it) { float* tp = tp0 + it * 8 * 65; tp[0] = v[it][0]; tp[1] = v[it][1]; tp[2] = v[it][2]; tp[3] = v[it][3]; }
    __syncthreads();
#pragma unroll
    for (int j = 0; j < 4; ++j) {
        const int nn = tid >> 3, k8 = (tid & 7) * 8;
        const float* tp = T + j * 4160 + k8 * 65 + nn;
        u32x4 o = {pk_bf16(tp[0], tp[65]), pk_bf16(tp[130], tp[195]), pk_bf16(tp[260], tp[325]), pk_bf16(tp[390], tp[455])};
        *(u32x4*)(J[j].dst + (size_t)nn * J[j].lddst + k8) = o;
    }
    __syncthreads();
}

constexpr int CONV_PER_LAYER = 1024 + 48 + 64 + 256 + 256 + 16384 + 8192;

__device__ __forceinline__ void conv_decode(const Args& a, int job, ConvJob& J) {
    const int l = job / CONV_PER_LAYER; int r = job % CONV_PER_LAYER;
    unsigned char* ws = a.ws;
    J.kscale = nullptr; J.Kvalid = 1 << 30; J.Nvalid = 1 << 30;
    if (r < 1024) {
        const int kt = r >> 6, ntl = r & 63;
        J.src = a.in[6] + (size_t)l * 1024 * INW; J.ldsrc = INW; J.k0 = kt * 64; J.n0 = ntl * 64; J.Nvalid = INW;
        J.dst = (bf16_t*)(ws + WS_WTIN) + (size_t)l * INWP * 1024 + (size_t)(ntl * 64) * 1024 + kt * 64; J.lddst = 1024; return;
    }
    r -= 1024;
    if (r < 48) {
        const int kt = r / 12, ntl = r % 12;
        J.src = a.in[10] + (size_t)l * 256 * 768; J.ldsrc = 768; J.k0 = kt * 64; J.n0 = ntl * 64; J.kscale = a.in[8] + l * 256;
        J.dst = (bf16_t*)(ws + WS_WTUQ) + (size_t)l * 768 * 256 + (size_t)(ntl * 64) * 256 + kt * 64; J.lddst = 256; return;
    }
    r -= 48;
    if (r < 64) {
        const int kt = r >> 4, ntl = r & 15;
        J.src = (ntl < 8 ? a.in[11] : a.in[12]) + (size_t)l * 128 * 512; J.ldsrc = 512; J.k0 = kt * 64; J.n0 = (ntl & 7) * 64; J.Kvalid = 128; J.kscale = a.in[9] + l * 128;
        J.dst = (bf16_t*)(ws + WS_WTUKV) + (size_t)l * 1024 * 256 + (size_t)(ntl * 64) * 256 + kt * 64; J.lddst = 256; return;
    }
    r -= 64;
    if (r < 256) {
        const int kt = r >> 4, ntl = r & 15;
        J.src = (kt < 8 ? a.in[13] : a.in[16]) + (size_t)l * 512 * 1024; J.ldsrc = 1024; J.k0 = (kt & 7) * 64; J.n0 = ntl * 64;
        J.dst = (bf16_t*)(ws + WS_WTOAB) + (size_t)l * 1024 * 1024 + (size_t)(kt >> 3) * 1024 * 512 + (size_t)(ntl * 64) * 512 + (kt & 7) * 64; J.lddst = 512; return;
    }
    r -= 256;
    if (r < 256) {
        const int kt = r >> 4, ntl = r & 15;
        J.src = a.in[17] + (size_t)l * 1024 * 1024; J.ldsrc = 1024; J.k0 = kt * 64; J.n0 = ntl * 64;
        J.dst = (bf16_t*)(ws + WS_WTO) + (size_t)l * 1024 * 1024 + (size_t)(ntl * 64) * 1024 + kt * 64; J.lddst = 1024; return;
    }
    r -= 256;
    if (r < 16384) {
        const int e = r >> 9, rr = r & 511, kt = rr >> 5, ntl = rr & 31, n0 = ntl * 64;
        J.src = a.in[24] + ((size_t)(l * NEXP + e)) * 1024 * 2048; J.ldsrc = 2048; J.k0 = kt * 64; J.n0 = n0;
        const int jj = n0 & 1023, row0 = (jj >> 7) * 256 + (n0 >= 1024 ? 128 : 0) + (jj & 127);
        J.dst = (bf16_t*)(ws + WS_WTGU) + ((size_t)(l * NEXP + e)) * 2048 * 1024 + (size_t)row0 * 1024 + kt * 64; J.lddst = 1024; return;
    }
    r -= 16384;
    {
        const int e = r >> 8, rr = r & 255, kt = rr >> 4, ntl = rr & 15;
        J.src = a.in[26] + ((size_t)(l * NEXP + e)) * 1024 * 1024; J.ldsrc = 1024; J.k0 = kt * 64; J.n0 = ntl * 64;
        J.dst = (bf16_t*)(ws + WS_WTDN) + ((size_t)(l * NEXP + e)) * 1024 * 1024 + (size_t)(ntl * 64) * 1024 + kt * 64; J.lddst = 1024;
    }
}

__device__ __forceinline__ void p0_phase(const Args& a, unsigned char* ldsg, const int wid_s) {
    const int tid = mk_tid(wid_s), G = gridDim.x, bid = blockIdx.x;
    float* LF = (float*)ldsg;
    if (bid == 0) { ((int*)(a.ws + WS_CTL))[tid] = 0; ((int*)(a.ws + WS_CTL))[tid + 512] = 0; }
    for (int idx = bid * NTHREADS + tid; idx < SEQ * 16; idx += G * NTHREADS) {
        const int t = idx >> 4, i = idx & 15;
        const float pos = (float)((i < 8) ? (t >> 6) : (t & 63));
        const float fr_ = powf(10000.0f, -(float)(2 * (i & 7)) / 16.0f);
        const float ang = pos * fr_;
        const double turns = (double)ang * 0.15915494309189535;
        const float frac = (float)(turns - rint(turns));
        ((float2*)(a.ws + WS_ROPE))[idx] = make_float2(__builtin_amdgcn_cosf(frac), __builtin_amdgcn_sinf(frac));
    }
    for (int job = bid; job < DEPTH * 96; job += G) {
        const int l = job / 96, g = job % 96;
        for (int i = tid; i < 5 * 1024; i += NTHREADS) {
            const int m = i >> 10, k = i & 1023;
            const float c = (m < 4) ? a.in[1][m * 1024 + k] : a.in[3][k];
            LF[i] = c / (1.0f + __expf(-c));
        }
        __syncthreads();
        const int col = g * 64 + (tid & 63), kq = tid >> 6;
        const float* w = a.in[4] + (size_t)l * 1024 * 6144 + col;
        float s0 = 0.f, s1 = 0.f, s2 = 0.f, s3 = 0.f, s4 = 0.f;
#pragma unroll 32
        for (int k = kq * 128; k < kq * 128 + 128; ++k) {
            const float wv = w[(size_t)k * 6144];
            s0 += LF[k] * wv; s1 += LF[1024 + k] * wv; s2 += LF[2048 + k] * wv; s3 += LF[3072 + k] * wv; s4 += LF[4096 + k] * wv;
        }
        float* red = LF + 5120;
        red[(kq * 5 + 0) * 64 + (tid & 63)] = s0; red[(kq * 5 + 1) * 64 + (tid & 63)] = s1; red[(kq * 5 + 2) * 64 + (tid & 63)] = s2;
        red[(kq * 5 + 3) * 64 + (tid & 63)] = s3; red[(kq * 5 + 4) * 64 + (tid & 63)] = s4;
        __syncthreads();
        if (tid < 320) {
            const int m = tid >> 6, cc = tid & 63; float s = 0.f;
#pragma unroll
            for (int q = 0; q < 8; ++q) s += red[(q * 5 + m) * 64 + cc];
            ((float*)(a.ws + WS_MOD))[((size_t)(l * 5 + m)) * 6144 + g * 64 + cc] = s + a.in[5][l * 6144 + g * 64 + cc];
        }
        __syncthreads();
    }
    for (int job = bid * 4; job < DEPTH * CONV_PER_LAYER; job += G * 4) { ConvJob J[4]; conv_decode(a, job, J[0]); conv_decode(a, job + 1, J[1]); conv_decode(a, job + 2, J[2]); conv_decode(a, job + 3, J[3]); conv_tile4(J, LF, tid); }
}

__device__ __forceinline__ void p1_phase(const Args& a, const int wid_s) {
    const int tid_ = mk_tid(wid_s);
    const int lane = tid_ & 63, gw = blockIdx.x * 8 + (tid_ >> 6), nw = gridDim.x * 8;
    const float* mod = (const float*)(a.ws + WS_MOD);
    bf16_t* HB = (bf16_t*)(a.ws + WS_HB);
    f32x4 xn[4];
    const float* const x_in = a.in[0]; const float* const c_in = a.in[2];
#define P1_LOAD(Rq) do { const int Rc_ = min((Rq), MR - 1); const int b_ = Rc_ / RPB, j_ = Rc_ % RPB; \
        const float* src_ = (j_ < CTXL) ? c_in + ((size_t)(b_ * CTXL + j_)) * 1024 : x_in + ((size_t)(b_ * SEQ + j_ - CTXL)) * 1024; \
        _Pragma("unroll") for (int i = 0; i < 4; ++i) xn[i] = *(const f32x4*)(src_ + (lane + 64 * i) * 4); } while (0)
    P1_LOAD(gw);
    for (int R = gw; R < MR; R += nw) {
        const int b = R / RPB, j = R % RPB;
        const float* md = mod + (size_t)((j < CTXL) ? 4 : b) * 6144;
        f32x4 xc[4];
#pragma unroll
        for (int i = 0; i < 4; ++i) xc[i] = xn[i];
        P1_LOAD(R + nw);
#pragma unroll
        for (int i = 0; i < 4; ++i) {
            const int k = (lane + 64 * i) * 4;
            const f32x4 sh = *(const f32x4*)(md + k), sc = *(const f32x4*)(md + 1024 + k);
            const f32x4 h = xc[i] * (sc + 1.0f) + sh;
            u32x2 o = {pk_bf16(h[0], h[1]), pk_bf16(h[2], h[3])};
            *(u32x2*)(HB + (size_t)R * 1024 + k) = o;
        }
    }
#undef P1_LOAD
}

__device__ __forceinline__ void rowa_phase(const Args& a, int l, const int wid_s) {
    const int tid_ = mk_tid(wid_s);
    const int lane = tid_ & 63, gw = blockIdx.x * 8 + (tid_ >> 6), nw = gridDim.x * 8;
    const bf16_t* P = (const bf16_t*)(a.ws + WS_P);
    float* rsq = (float*)(a.ws + WS_RSQ); float* rskv = (float*)(a.ws + WS_RSKV);
    bf16_t* KR = (bf16_t*)(a.ws + WS_KR); bf16_t* AC = (bf16_t*)(a.ws + WS_AC);
    const float2* cs = (const float2*)(a.ws + WS_ROPE);
    const float* cw = a.in[14] + (size_t)l * 3 * 512; const float* cb = a.in[15] + (size_t)l * 512;
    const int c8 = lane * 8;
    float w0[8], w1[8], w2[8], bs[8];
#pragma unroll
    for (int e = 0; e < 8; ++e) { w0[e] = cw[c8 + e]; w1[e] = cw[512 + c8 + e]; w2[e] = cw[1024 + c8 + e]; bs[e] = cb[c8 + e]; }
    u32x2 nqa; unsigned nka; bf16_t nkr; u32x4 nuc, nbc, ncc, nup, ncp, nun, ncn;
#define RA_LOAD(Rq) do { const int Rc_ = min((Rq), MR - 1); const bf16_t* pr_ = P + (size_t)Rc_ * INWP; const int j_ = Rc_ % RPB; \
        const bool hp_ = (j_ != 0) && (j_ != CTXL), hn_ = (j_ != CTXL - 1) && (j_ != RPB - 1); const u32x4 z_ = {0u, 0u, 0u, 0u}; \
        nqa = *(const u32x2*)(pr_ + lane * 4); nka = *(const unsigned*)(pr_ + OFF_KV + lane * 2); nkr = pr_[OFF_KR + (lane & 31)]; \
        nuc = *(const u32x4*)(pr_ + OFF_CX + c8); nbc = *(const u32x4*)(pr_ + OFF_CB + c8); ncc = *(const u32x4*)(pr_ + OFF_CC + c8); \
        nup = hp_ ? *(const u32x4*)(pr_ - INWP + OFF_CX + c8) : z_; ncp = hp_ ? *(const u32x4*)(pr_ - INWP + OFF_CC + c8) : z_; \
        nun = hn_ ? *(const u32x4*)(pr_ + INWP + OFF_CX + c8) : z_; ncn = hn_ ? *(const u32x4*)(pr_ + INWP + OFF_CC + c8) : z_; } while (0)
    RA_LOAD(gw);
    for (int R = gw; R < MR; R += nw) {
        const int j = R % RPB;
        const u32x2 qa = nqa; const unsigned ka = nka; const bf16_t krv = nkr;
        const u32x4 uc = nuc, bc = nbc, cc = ncc, up = nup, cp = ncp, un = nun, cn = ncn;
        RA_LOAD(R + nw);
        float sq = bf_lo(qa[0]) * bf_lo(qa[0]) + bf_hi(qa[0]) * bf_hi(qa[0]) + bf_lo(qa[1]) * bf_lo(qa[1]) + bf_hi(qa[1]) * bf_hi(qa[1]);
        float sk = bf_lo(ka) * bf_lo(ka) + bf_hi(ka) * bf_hi(ka);
        sq = wave_sum(sq, lane); sk = wave_sum(sk, lane);
        if (lane == 0) { rsq[R] = rsqrtf(sq * (1.0f / 256.0f) + NORM_EPS); rskv[R] = rsqrtf(sk * (1.0f / 128.0f) + NORM_EPS); }
        {
            const float v = bf2f(krv);
            const float pv = swz<8>(v);
            float o = v;
            if (j >= CTXL) { const int i = lane & 31; const float2 c2 = cs[(size_t)(j - CTXL) * 16 + (i >> 4) * 8 + (i & 7)]; o = v * c2.x + (((i >> 3) & 1) ? pv : -pv) * c2.y; }
            const float o2 = swz<1>(o);
            if (lane < 32 && !(lane & 1)) *(unsigned*)(KR + (size_t)R * 32 + lane) = pk_bf16(o, o2);
        }
        float y[8];
#pragma unroll
        for (int e = 0; e < 8; ++e) {
            const int q = e >> 1;
            const float zc = (e & 1) ? bf_hi(uc[q]) * bf_hi(cc[q]) : bf_lo(uc[q]) * bf_lo(cc[q]);
            const float zp = (e & 1) ? bf_hi(up[q]) * bf_hi(cp[q]) : bf_lo(up[q]) * bf_lo(cp[q]);
            const float zn = (e & 1) ? bf_hi(un[q]) * bf_hi(cn[q]) : bf_lo(un[q]) * bf_lo(cn[q]);
            const float bg = (e & 1) ? bf_hi(bc[q]) : bf_lo(bc[q]);
            y[e] = bg * (w0[e] * zp + w1[e] * zc + w2[e] * zn + bs[e]);
        }
        u32x4 o = {pk_bf16(y[0], y[1]), pk_bf16(y[2], y[3]), pk_bf16(y[4], y[5]), pk_bf16(y[6], y[7])};
        *(u32x4*)(AC + (size_t)R * 1024 + 512 + c8) = o;
    }
#undef RA_LOAD
}

__device__ __forceinline__ void router_tail(const f32x16 plo, const f32x16 phi, const int lane, const float* br_, const bool live, const int lrow, int* lcnt, int* rec_e, int* rec_p, float* rec_g) {
    const bool u5 = (lane & 32) != 0, u4 = (lane & 16) != 0, u3 = (lane & 8) != 0, u2 = (lane & 4) != 0, u1 = (lane & 2) != 0;
    f32x16 k16 = u5 ? phi : plo; const f32x16 s16 = u5 ? plo : phi;
#pragma unroll
    for (int i = 0; i < 16; ++i) k16[i] += shx32(s16[i], lane);
    f32x8 k8 = u4 ? k16.hi : k16.lo; const f32x8 s8 = u4 ? k16.lo : k16.hi;
#pragma unroll
    for (int i = 0; i < 8; ++i) k8[i] += swz<16>(s8[i]);
    f32x4 k4 = u3 ? k8.hi : k8.lo; const f32x4 s4 = u3 ? k8.lo : k8.hi;
#pragma unroll
    for (int i = 0; i < 4; ++i) k4[i] += swz<8>(s4[i]);
    f32x2 k2 = u2 ? k4.hi : k4.lo; const f32x2 s2 = u2 ? k4.lo : k4.hi;
#pragma unroll
    for (int i = 0; i < 2; ++i) k2[i] += swz<4>(s2[i]);
    float k1 = u1 ? k2.y : k2.x; const float s1 = u1 ? k2.x : k2.y;
    k1 += swz<2>(s1);
    const int myE = lane >> 1;
    const float mylog = k1 + swz<1>(k1) + br_[myE];
    int rank = 0;
#pragma unroll
    for (int e = 0; e < 32; ++e) {
        const float le = __uint_as_float(__builtin_amdgcn_readlane(__float_as_uint(mylog), 2 * e));
        rank += ((le > mylog) || (le == mylog && e < myE)) ? 1 : 0;
    }
    const bool even = !(lane & 1);
    const unsigned long long m0 = __ballot(even && rank == 0), m1 = __ballot(even && rank == 1), m2 = __ballot(even && rank == 2), m3 = __ballot(even && rank == 3);
    const float v0 = __uint_as_float(__builtin_amdgcn_readlane(__float_as_uint(mylog), __builtin_ctzll(m0)));
    const float v1 = __uint_as_float(__builtin_amdgcn_readlane(__float_as_uint(mylog), __builtin_ctzll(m1)));
    const float v2 = __uint_as_float(__builtin_amdgcn_readlane(__float_as_uint(mylog), __builtin_ctzll(m2)));
    const float v3 = __uint_as_float(__builtin_amdgcn_readlane(__float_as_uint(mylog), __builtin_ctzll(m3)));
    const float inv = 1.0f / (1.0f + __expf(v1 - v0) + __expf(v2 - v0) + __expf(v3 - v0));
    if (live && even && rank < 4) {
        const float g = __expf(mylog - v0) * inv;
        const int lp = atomicAdd(&lcnt[myE], 1);
        const int li = lrow * 4 + rank;
        rec_e[li] = myE; rec_p[li] = lp; rec_g[li] = g;
    }
}

__device__ __forceinline__ void ln1_router_phase(const Args& a, int l, unsigned char* ldsg, const int wid_s) {
    const int tid_ = mk_tid(wid_s);
    const int tid = tid_, lane = tid & 63, wid = tid >> 6, G = gridDim.x, bid = blockIdx.x;
    float* WT = (float*)ldsg;
    int* lcnt = (int*)(ldsg + MISC_OFF);
    int* lbase = lcnt + 32;
    int* rec_e = lbase + 32;
    int* rec_p = rec_e + 1024;
    float* rec_g = (float*)(rec_p + 1024);
    const float* wr_ = a.in[22] + (size_t)l * 1024 * 32; const float* br_ = a.in[23] + l * 32;
    {
        f32x4 wv[16];
#pragma unroll
        for (int j = 0; j < 16; ++j) wv[j] = *(const f32x4*)(wr_ + (size_t)(tid + NTHREADS * j) * 4);
#pragma unroll
        for (int j = 0; j < 16; ++j) { const int idx = (tid + NTHREADS * j) * 4, k = idx >> 5, e = idx & 31;
#pragma unroll
            for (int c = 0; c < 4; ++c) WT[(e + c) * 1024 + k] = wv[j][c]; }
    }
    if (tid < 32) lcnt[tid] = 0;
    __syncthreads();
    const int rpb = (MR + G - 1) / G, r0 = bid * rpb, r1 = min(MR, r0 + rpb);
    float* RES = (float*)(a.ws + WS_RES); bf16_t* HB = (bf16_t*)(a.ws + WS_HB);
    const float* mod = (const float*)(a.ws + WS_MOD) + (size_t)l * 5 * 6144;
    const float* lg_ = a.in[18] + l * 1024; const float* lb_ = a.in[19] + l * 1024;
    const bool lastl = (l == DEPTH - 1);
    f32x4 na[4], nb[4];
#define L1_LOAD(Rq) do { const int Ra_ = min((Rq), MR - 1), Rb_ = min((Rq) + 8, MR - 1); _Pragma("unroll") for (int i = 0; i < 4; ++i) { \
        na[i] = *(const f32x4*)(RES + (size_t)Ra_ * 1024 + (lane + 64 * i) * 4); nb[i] = *(const f32x4*)(RES + (size_t)Rb_ * 1024 + (lane + 64 * i) * 4); } } while (0)
    L1_LOAD(r0 + wid);
    for (int Ra = r0 + wid; Ra < r1; Ra += 16) {
        const bool has2 = (Ra + 8 < r1);
        const int Rb = has2 ? Ra + 8 : Ra;
        f32x4 va[4], vb[4];
#pragma unroll
        for (int i = 0; i < 4; ++i) { va[i] = na[i]; vb[i] = has2 ? nb[i] : na[i]; }
        L1_LOAD(Ra + 16);
        const int ja = Ra % RPB, jb = Rb % RPB;
        const bool livea = !(lastl && ja < CTXL), liveb = has2 && !(lastl && jb < CTXL);
        if (!livea && !liveb) continue;
        const float* mda = mod + (size_t)((ja < CTXL) ? 4 : Ra / RPB) * 6144;
        const float* mdb = mod + (size_t)((jb < CTXL) ? 4 : Rb / RPB) * 6144;
        float sa_ = 0.f, sb_ = 0.f;
#pragma unroll
        for (int i = 0; i < 4; ++i) { sa_ += va[i][0] + va[i][1] + va[i][2] + va[i][3]; sb_ += vb[i][0] + vb[i][1] + vb[i][2] + vb[i][3]; }
        const float mua = wave_sum(sa_, lane) * (1.0f / 1024.0f), mub = wave_sum(sb_, lane) * (1.0f / 1024.0f);
        float qa = 0.f, qb = 0.f;
#pragma unroll
        for (int i = 0; i < 4; ++i) { va[i] = va[i] - mua; vb[i] = vb[i] - mub; qa += va[i][0] * va[i][0] + va[i][1] * va[i][1] + va[i][2] * va[i][2] + va[i][3] * va[i][3]; qb += vb[i][0] * vb[i][0] + vb[i][1] * vb[i][1] + vb[i][2] * vb[i][2] + vb[i][3] * vb[i][3]; }
        const float rsa = rsqrtf(wave_sum(qa, lane) * (1.0f / 1024.0f) + NORM_EPS), rsb = rsqrtf(wave_sum(qb, lane) * (1.0f / 1024.0f) + NORM_EPS);
        f32x2 hp[4][4];
#pragma unroll
        for (int i = 0; i < 4; ++i) {
            const int k = (lane + 64 * i) * 4;
            const f32x4 gg = *(const f32x4*)(lg_ + k), bb = *(const f32x4*)(lb_ + k);
            const f32x4 xa = va[i] * rsa * gg + bb, xb = vb[i] * rsb * gg + bb;
            const f32x4 ha = xa * (*(const f32x4*)(mda + 4096 + k) + 1.0f) + *(const f32x4*)(mda + 3072 + k);
            const f32x4 hb = xb * (*(const f32x4*)(mdb + 4096 + k) + 1.0f) + *(const f32x4*)(mdb + 3072 + k);
#pragma unroll
            for (int c = 0; c < 4; ++c) hp[i][c] = (f32x2){ha[c], hb[c]};
            if (livea) { *(f32x4*)(RES + (size_t)Ra * 1024 + k) = xa; u32x2 o = {pk_bf16(ha[0], ha[1]), pk_bf16(ha[2], ha[3])}; *(u32x2*)(HB + (size_t)Ra * 1024 + k) = o; }
            if (liveb) { *(f32x4*)(RES + (size_t)Rb * 1024 + k) = xb; u32x2 o = {pk_bf16(hb[0], hb[1]), pk_bf16(hb[2], hb[3])}; *(u32x2*)(HB + (size_t)Rb * 1024 + k) = o; }
        }
        f32x2 pl2[32];
#pragma unroll
        for (int e = 0; e < 32; ++e) {
            f32x2 acc2 = {0.f, 0.f};
#pragma unroll
            for (int i = 0; i < 4; ++i) {
                const f32x4 w = *(const f32x4*)(WT + e * 1024 + (lane + 64 * i) * 4);
#pragma unroll
                for (int c = 0; c < 4; ++c) acc2 = __builtin_elementwise_fma(hp[i][c], (f32x2){w[c], w[c]}, acc2);
            }
            pl2[e] = acc2;
            if ((e & 3) == 3) __builtin_amdgcn_sched_barrier(0);
        }
        {
            const f32x16 plo = {pl2[0].x, pl2[1].x, pl2[2].x, pl2[3].x, pl2[4].x, pl2[5].x, pl2[6].x, pl2[7].x, pl2[8].x, pl2[9].x, pl2[10].x, pl2[11].x, pl2[12].x, pl2[13].x, pl2[14].x, pl2[15].x};
            const f32x16 phi = {pl2[16].x, pl2[17].x, pl2[18].x, pl2[19].x, pl2[20].x, pl2[21].x, pl2[22].x, pl2[23].x, pl2[24].x, pl2[25].x, pl2[26].x, pl2[27].x, pl2[28].x, pl2[29].x, pl2[30].x, pl2[31].x};
            router_tail(plo, phi, lane, br_, livea, Ra - r0, lcnt, rec_e, rec_p, rec_g);
        }
        {
            const f32x16 plo = {pl2[0].y, pl2[1].y, pl2[2].y, pl2[3].y, pl2[4].y, pl2[5].y, pl2[6].y, pl2[7].y, pl2[8].y, pl2[9].y, pl2[10].y, pl2[11].y, pl2[12].y, pl2[13].y, pl2[14].y, pl2[15].y};
            const f32x16 phi = {pl2[16].y, pl2[17].y, pl2[18].y, pl2[19].y, pl2[20].y, pl2[21].y, pl2[22].y, pl2[23].y, pl2[24].y, pl2[25].y, pl2[26].y, pl2[27].y, pl2[28].y, pl2[29].y, pl2[30].y, pl2[31].y};
            router_tail(plo, phi, lane, br_, liveb, Rb - r0, lcnt, rec_e, rec_p, rec_g);
        }
    }
#undef L1_LOAD
    __syncthreads();
    if (tid < 32) lbase[tid] = atomicAdd((int*)(a.ws + WS_CTL) + l * 32 + tid, lcnt[tid]);
    __syncthreads();
    int* RE = (int*)(a.ws + WS_RE); int* RP = (int*)(a.ws + WS_RPOS); float* RG = (float*)(a.ws + WS_RG);
    for (int i = tid; i < (r1 - r0) * 4; i += NTHREADS) {
        if (lastl && ((r0 + (i >> 2)) % RPB) < CTXL) continue;
        const int e = rec_e[i];
        RE[(size_t)r0 * 4 + i] = e; RP[(size_t)r0 * 4 + i] = lbase[e] + rec_p[i]; RG[(size_t)r0 * 4 + i] = rec_g[i];
    }
    __syncthreads();
}

__device__ __forceinline__ void moe_prefix(const Args& a, int l, unsigned char* ldsg, const int wid_s) {
    int* ts = (int*)(ldsg + MISC_OFF);
    __syncthreads();
    if (wid_s == 0 && lane_id() == 0) {
        const int* cnt = (const int*)(a.ws + WS_CTL) + l * 32; int acc_ = 0;
#pragma unroll 1
        for (int e = 0; e < 32; ++e) { ts[e] = acc_; ts[40 + e] = __hip_atomic_load(cnt + e, __ATOMIC_RELAXED, __HIP_MEMORY_SCOPE_AGENT); acc_ += (__hip_atomic_load(cnt + e, __ATOMIC_RELAXED, __HIP_MEMORY_SCOPE_AGENT) + 255) >> 8; }
        ts[32] = acc_;
    }
    __syncthreads();
}

__device__ __forceinline__ void gather_phase(const Args& a, int l, unsigned char* ldsg, const int wid_s) {
    moe_prefix(a, l, ldsg, wid_s);
    const int* ts = (const int*)(ldsg + MISC_OFF);
    const int tid = mk_tid(wid_s);
    const int* RE = (const int*)(a.ws + WS_RE); const int* RP = (const int*)(a.ws + WS_RPOS); const float* RG = (const float*)(a.ws + WS_RG);
    int* SO = (int*)(a.ws + WS_SLOTOF); float* GWS = (float*)(a.ws + WS_GWS); int* RO = (int*)(a.ws + WS_ROWOFF);
    const int G = gridDim.x;
    for (int i = blockIdx.x * NTHREADS + tid; i < MR * 4; i += G * NTHREADS) {
        const int R = i >> 2;
        if (l == DEPTH - 1 && (R % RPB) < CTXL) continue;
        const int slot = ts[RE[i] & 31] * 256 + RP[i];
        SO[i] = slot; GWS[slot] = RG[i]; RO[slot] = R * 2048;
    }
    for (int e = blockIdx.x; e < NEXP; e += G) {
        const int beg = ts[e] * 256 + ts[40 + e], end = ts[e + 1] * 256;
        for (int sl = beg + tid; sl < end; sl += NTHREADS) { RO[sl] = 0; GWS[sl] = 0.f; }
    }
}

__device__ __forceinline__ void ln2_phase(const Args& a, int l, const int wid_s) {
    const int tid_ = mk_tid(wid_s);
    const int lane = tid_ & 63, gw = blockIdx.x * 8 + (tid_ >> 6), nw = gridDim.x * 8;
    float* RES = (float*)(a.ws + WS_RES); bf16_t* HB = (bf16_t*)(a.ws + WS_HB); const bf16_t* YS = (const bf16_t*)(a.ws + WS_AS);
    const int* SO = (const int*)(a.ws + WS_SLOTOF);
    const float* mod = (const float*)(a.ws + WS_MOD) + (size_t)l * 5 * 6144;
    const float* modn = (const float*)(a.ws + WS_MOD) + (size_t)((l + 1) % DEPTH) * 5 * 6144;
    const float* lg_ = a.in[20] + l * 1024; const float* lb_ = a.in[21] + l * 1024;
    const bool last = (l == DEPTH - 1);
    int sl1[4], sl2[4];
    u32x2 ysn[4][4]; f32x4 rsn[4];
#define LN2_SLOTS(dst, Rq) do { const int Rc_ = min((Rq), MR - 1); _Pragma("unroll") for (int k = 0; k < 4; ++k) dst[k] = SO[Rc_ * 4 + k]; } while (0)
#define LN2_ROWS(Rq, slq) do { const int Rc_ = min((Rq), MR - 1); const bool skip_ = last && (Rc_ % RPB) < CTXL; _Pragma("unroll") for (int i = 0; i < 4; ++i) { const int k0_ = (lane + 64 * i) * 4; \
        rsn[i] = *(const f32x4*)(RES + (size_t)Rc_ * 1024 + k0_); _Pragma("unroll") for (int k = 0; k < 4; ++k) ysn[i][k] = *(const u32x2*)(YS + (size_t)(skip_ ? 0 : slq[k]) * 1024 + k0_); } } while (0)
    LN2_SLOTS(sl1, gw); LN2_SLOTS(sl2, gw + nw);
    LN2_ROWS(gw, sl1);
#pragma unroll
    for (int k = 0; k < 4; ++k) sl1[k] = sl2[k];
    for (int R = gw; R < MR; R += nw) {
        u32x2 ys[4][4]; f32x4 v[4];
#pragma unroll
        for (int i = 0; i < 4; ++i) { v[i] = rsn[i];
#pragma unroll
            for (int k = 0; k < 4; ++k) ys[i][k] = ysn[i][k]; }
        LN2_SLOTS(sl2, R + 2 * nw);
        LN2_ROWS(R + nw, sl1);
#pragma unroll
        for (int k = 0; k < 4; ++k) sl1[k] = sl2[k];
        const int b = R / RPB, j = R % RPB; const int mi = (j < CTXL) ? 4 : b;
        if (last && j < CTXL) continue;
        const float* md = mod + (size_t)mi * 6144;
        float* rr = RES + (size_t)R * 1024;
        float s = 0.f;
#pragma unroll
        for (int i = 0; i < 4; ++i) {
            const int k0 = (lane + 64 * i) * 4;
            f32x4 f = {0.f, 0.f, 0.f, 0.f};
#pragma unroll
            for (int k = 0; k < 4; ++k) { const u32x2 y = ys[i][k]; f[0] += bf_lo(y[0]); f[1] += bf_hi(y[0]); f[2] += bf_lo(y[1]); f[3] += bf_hi(y[1]); }
            v[i] = v[i] * DN_ALPHA + *(const f32x4*)(md + 5120 + k0) * f;
            s += v[i][0] + v[i][1] + v[i][2] + v[i][3];
        }
        const float mu = wave_sum(s, lane) * (1.0f / 1024.0f);
        float q = 0.f;
#pragma unroll
        for (int i = 0; i < 4; ++i) { v[i] = v[i] - mu; q += v[i][0] * v[i][0] + v[i][1] * v[i][1] + v[i][2] * v[i][2] + v[i][3] * v[i][3]; }
        const float rstd = rsqrtf(wave_sum(q, lane) * (1.0f / 1024.0f) + NORM_EPS);
#pragma unroll
        for (int i = 0; i < 4; ++i) {
            const int k0 = (lane + 64 * i) * 4;
            const f32x4 x2 = v[i] * rstd * *(const f32x4*)(lg_ + k0) + *(const f32x4*)(lb_ + k0);
            if (last) { *(f32x4*)(a.out + ((size_t)(b * SEQ + j - CTXL)) * 1024 + k0) = x2; }
            else {
                *(f32x4*)(rr + k0) = x2;
                const float* mn = modn + (size_t)mi * 6144;
                const f32x4 h = x2 * (*(const f32x4*)(mn + 1024 + k0) + 1.0f) + *(const f32x4*)(mn + k0);
                u32x2 o = {pk_bf16(h[0], h[1]), pk_bf16(h[2], h[3])};
                *(u32x2*)(HB + (size_t)R * 1024 + k0) = o;
            }
        }
    }
#undef LN2_SLOTS
#undef LN2_ROWS
}

constexpr int KROW = 208, VROW = 136, KBUF = 64 * KROW, VBUF = 64 * VROW, KVBUF = KBUF + VBUF;

template <int MODE> __device__ __forceinline__ f32x16 att_mma(const bf16x8 a_, const bf16x8 b_, f32x16 c_) {
    if (MODE == 2) { c_[0] += __builtin_bit_cast(f32x4, a_)[0] + __builtin_bit_cast(f32x4, b_)[1]; return c_; }
    return __builtin_amdgcn_mfma_f32_32x32x16_bf16(a_, b_, c_, 0, 0, 0);
}
#define ATT_MMA(a_, b_, c_, x_, y_, z_) att_mma<MODE>(a_, b_, c_)
template <int MODE>
__device__ __forceinline__ void attn_qk(const LAS unsigned char* kb_, const bf16x8 (&qf)[6], f32x16 (&st)[2], const int ql, const int hf) {
#define ATT_KF(kb, s) (*(const LAS bf16x8*)(kb_ + ((kb) * 32 + ql) * KROW + (s) * 32 + hf * 16))
    bf16x8 ka[4], kc[4], ke[4];
#pragma unroll
    for (int s = 0; s < 2; ++s) { ka[2 * s] = ATT_KF(0, s); ka[2 * s + 1] = ATT_KF(1, s); }
#pragma unroll
    for (int s = 2; s < 4; ++s) { kc[2 * (s - 2)] = ATT_KF(0, s); kc[2 * (s - 2) + 1] = ATT_KF(1, s); }
    __builtin_amdgcn_sched_barrier(0);
#pragma unroll
    for (int i = 0; i < 16; ++i) { st[0][i] = 0.f; st[1][i] = 0.f; }
#pragma unroll
    for (int s = 0; s < 2; ++s) { st[0] = ATT_MMA(ka[2 * s], qf[s], st[0], 0, 0, 0); st[1] = ATT_MMA(ka[2 * s + 1], qf[s], st[1], 0, 0, 0); }
    __builtin_amdgcn_sched_barrier(0);
#pragma unroll
    for (int s = 4; s < 6; ++s) { ke[2 * (s - 4)] = ATT_KF(0, s); ke[2 * (s - 4) + 1] = ATT_KF(1, s); }
    __builtin_amdgcn_sched_barrier(0);
#pragma unroll
    for (int s = 2; s < 4; ++s) { st[0] = ATT_MMA(kc[2 * (s - 2)], qf[s], st[0], 0, 0, 0); st[1] = ATT_MMA(kc[2 * (s - 2) + 1], qf[s], st[1], 0, 0, 0); }
#pragma unroll
    for (int s = 4; s < 6; ++s) { st[0] = ATT_MMA(ke[2 * (s - 4)], qf[s], st[0], 0, 0, 0); st[1] = ATT_MMA(ke[2 * (s - 4) + 1], qf[s], st[1], 0, 0, 0); }
#undef ATT_KF
}
template <int MODE>
__device__ __forceinline__ void attn_pv(const LAS unsigned char* vb_, f32x16 (&st)[2], f32x16 (&ot)[2], float& mrun, float& lsum, const int ql, const int hf, const int lane) {
    if (MODE != 1) {
    float mx = max3f(st[0][0], st[1][0], st[0][1]), my = max3f(st[1][1], st[0][2], st[1][2]);
#pragma unroll
    for (int i = 3; i < 15; i += 2) { mx = max3f(mx, st[0][i], st[1][i]); my = max3f(my, st[0][i + 1], st[1][i + 1]); }
    mx = max3f(mx, st[0][15], st[1][15]); mx = max3f(mx, my, my);
    if (__builtin_amdgcn_ballot_w64(mx > mrun + 8.0f) != 0ull) {
        mx = fmaxf(mx, shx32(mx, lane));
        const float mnew = (mx > mrun + 8.0f) ? mx : mrun;
        const float alpha = fexp2(mrun - mnew);
        mrun = mnew; lsum *= alpha;
#pragma unroll
        for (int i = 0; i < 16; ++i) { ot[0][i] *= alpha; ot[1][i] *= alpha; }
    }
    float ps = 0.f;
#pragma unroll
    for (int kb = 0; kb < 2; ++kb)
#pragma unroll
        for (int i = 0; i < 16; ++i) { const float p = fexp2(st[kb][i] - mrun); st[kb][i] = p; ps += p; }
    lsum += ps;
    } else lsum += st[0][0];
#pragma unroll
    for (int kb = 0; kb < 2; ++kb)
#pragma unroll
        for (int sI = 0; sI < 2; ++sI) {
            u32x4 pw = {pk_bf16(st[kb][8 * sI + 0], st[kb][8 * sI + 1]), pk_bf16(st[kb][8 * sI + 2], st[kb][8 * sI + 3]),
                        pk_bf16(st[kb][8 * sI + 4], st[kb][8 * sI + 5]), pk_bf16(st[kb][8 * sI + 6], st[kb][8 * sI + 7])};
            const bf16x8 pf = __builtin_bit_cast(bf16x8, pw);
#pragma unroll
            for (int db = 0; db < 2; ++db) {
                const LAS unsigned char* vp = vb_ + (db * 32 + ql) * VROW + (kb * 32 + 16 * sI + 4 * hf) * 2;
                const u32x2 v0 = *(const LAS u32x2*)vp, v1 = *(const LAS u32x2*)(vp + 16);
                u32x4 vw = {v0[0], v0[1], v1[0], v1[1]};
                ot[db] = att_mma<MODE>(__builtin_bit_cast(bf16x8, vw), pf, ot[db]);
            }
        }
}

template <int MODE>
__device__ __forceinline__ void attn_phase(const Args& a, bool do_ctx, LAS unsigned char* lds, const int wid_s) {
    const int tid = mk_tid(wid_s);
    const int lane = tid & 63, wid = wid_s, ql = lane & 31, hf = lane >> 5, G = gridDim.x;
    const bf16_t* Q = (const bf16_t*)(a.ws + WS_Q); const bf16_t* KN = (const bf16_t*)(a.ws + WS_KN); const bf16_t* KR = (const bf16_t*)(a.ws + WS_KR);
    const bf16_t* VT = (const bf16_t*)(a.ws + WS_VT); bf16_t* AC = (bf16_t*)(a.ws + WS_AC);
    const int nitems = 1024 + (do_ctx ? 32 : 0);
    LAS unsigned char* const ldsv = lds + 2 * KBUF;
    for (int it = 0;; ++it) {
        const long L = (long)it * G + blockIdx.x; if (L >= nitems) break;
        int b, h, qt, nkt;
        if (L < 1024) { const int x = (int)(L % 8), q = (int)((L / 8) % 32), bh = (int)(L / 256) * 8 + x; b = bh >> 3; h = bh & 7; qt = q + 1; nkt = RPB / 64; }
        else { const int bh = (int)(L - 1024); b = bh >> 3; h = bh & 7; qt = 0; nkt = CTXL / 64; }
        const int rowbase = b * RPB;
        const int qrow = rowbase + qt * 256 + wid * 32 + ql;
        bf16x8 qf[6];
#pragma unroll
        for (int s = 0; s < 6; ++s) qf[s] = *(const bf16x8*)(Q + (size_t)qrow * 768 + h * 96 + s * 16 + hf * 8);
        const bf16_t* gkn = KN + ((size_t)(rowbase + (tid >> 3))) * 512 + h * 64 + (tid & 7) * 8;
        const bf16_t* gkr = KR + ((size_t)(rowbase + ((tid & 255) >> 2))) * 32 + (tid & 3) * 8;
        const bf16_t* gvt = VT + ((size_t)((b * NH + h) * 64 + (tid >> 3))) * RPB + (tid & 7) * 8;
        const unsigned skn = (unsigned)((tid >> 3) * KROW + (tid & 7) * 16);
        const unsigned skr = (unsigned)(((tid & 255) >> 2) * KROW + 128 + (tid & 3) * 16);
        const unsigned svt = (unsigned)((tid >> 3) * VROW + (tid & 7) * 16);
#define ATT_LOADK(rk, rr, kt_) do { if (MODE == 3 && (kt_) > 1) break; rk = *(const u32x4*)(gkn + (size_t)(kt_) * 64 * 512); rr = *(const u32x4*)(gkr + (size_t)(kt_) * 64 * 32); } while (0)
#define ATT_LOADV(rv, kt_) do { if (MODE == 3 && (kt_) > 1) break; rv = *(const u32x4*)(gvt + (size_t)(kt_) * 64); } while (0)
#define ATT_WRITEK(rk, rr, buf) do { LAS unsigned char* nb_ = lds + (buf) * KBUF; *(LAS u32x4*)(nb_ + skn) = rk; if (tid < 256) *(LAS u32x4*)(nb_ + skr) = rr; } while (0)
#define ATT_WRITEV(rv, buf) do { LAS u32x2* p_ = (LAS u32x2*)(ldsv + (buf) * VBUF + svt); u32x2 lo_ = {rv[0], rv[1]}, hi_ = {rv[2], rv[3]}; p_[0] = lo_; p_[1] = hi_; } while (0)
        u32x4 kK, kR, vV;
        ATT_LOADK(kK, kR, 0); ATT_LOADV(vV, 0);
        ATT_WRITEK(kK, kR, 0); ATT_WRITEV(vV, 0);
        ATT_LOADK(kK, kR, 1);
        ATT_WRITEK(kK, kR, 1);
        __syncthreads();
        f32x16 ot[2], sa[2], sb[2];
#pragma unroll
        for (int i = 0; i < 16; ++i) { ot[0][i] = 0.f; ot[1][i] = 0.f; }
        float mrun = -3.0e38f, lsum = 0.f;
        attn_qk<MODE>(lds, qf, sa, ql, hf);
        __syncthreads();
        for (int t = 0; t < nkt; t += 2) {
            if (t + 2 < nkt) ATT_LOADK(kK, kR, t + 2);
            ATT_LOADV(vV, t + 1);
            attn_qk<MODE>(lds + KBUF, qf, sb, ql, hf);
            __builtin_amdgcn_sched_barrier(0);
            attn_pv<MODE>(ldsv, sa, ot, mrun, lsum, ql, hf, lane);
            if (t + 2 < nkt) ATT_WRITEK(kK, kR, 0);
            ATT_WRITEV(vV, 1);
            __syncthreads();
            if (t + 3 < nkt) ATT_LOADK(kK, kR, t + 3);
            if (t + 2 < nkt) ATT_LOADV(vV, t + 2);
            if (t + 2 < nkt) attn_qk<MODE>(lds, qf, sa, ql, hf);
            __builtin_amdgcn_sched_barrier(0);
            attn_pv<MODE>(ldsv + VBUF, sb, ot, mrun, lsum, ql, hf, lane);
            if (t + 3 < nkt) ATT_WRITEK(kK, kR, 1);
            if (t + 2 < nkt) ATT_WRITEV(vV, 0);
            __syncthreads();
        }
#undef ATT_LOADK
#undef ATT_LOADV
#undef ATT_WRITEK
#undef ATT_WRITEV
        const float ltot = lsum + shx32(lsum, lane);
        const float inv = 1.0f / ltot;
        bf16_t* orow = AC + (size_t)qrow * 1024 + h * 64;
#pragma unroll
        for (int db = 0; db < 2; ++db)
#pragma unroll
            for (int g = 0; g < 4; ++g) {
                u32x2 o = {pk_bf16(ot[db][4 * g + 0] * inv, ot[db][4 * g + 1] * inv), pk_bf16(ot[db][4 * g + 2] * inv, ot[db][4 * g + 3] * inv)};
                if (MODE == 0 || (o[0] == 0x12345678u && o[1] == 0x9abcdef1u)) *(u32x2*)(orow + db * 32 + 8 * g + 4 * hf) = o;
            }
    }
}

__global__ void __launch_bounds__(NTHREADS, 2) mk_fwd(Args a) {
    extern __shared__ __attribute__((aligned(16))) unsigned char lds[];
    cg::grid_group grid = cg::this_grid();
    LAS unsigned char* ldsl = (LAS unsigned char*)lds;
    const int G = gridDim.x, bid = blockIdx.x;
    const int wid_s = __builtin_amdgcn_readfirstlane((int)(threadIdx.x >> 6));
    unsigned char* ws = a.ws;
    unsigned* gbar = (unsigned*)(ws + WS_CTL) + 128; unsigned gep = 0;

    REP(2) if (PH & 1) p0_phase(a, lds, wid_s);
    __threadfence();
    grid.sync();
    if (PH & 2) p1_phase(a, wid_s);
    gsync(gbar, ++gep, wid_s);

    for (int l = 0; l < DEPTH; ++l) {
        if (DUP & 128) { for (int q_ = 0; q_ < 20; ++q_) gsync(gbar, ++gep, wid_s); }
        REP(3) if (PH & 4) {
            pg8::SchedDense S{(const char*)(ws + WS_HB), (size_t)256 * 1024 * 2, (const char*)(ws + WS_WTIN) + (size_t)l * INWP * 1024 * 2, (size_t)256 * 1024 * 2, MR / 256, INWP / 256, G, bid, 0};
            EpiInproj E{(bf16_t*)(ws + WS_P), a.in[7] + (size_t)l * INW};
            pg8::gemm_phase(ldsl, 1024, 1024, S, E, wid_s);
        }
        if (DUP & 2048) {
            pg8::SchedDense S{(const char*)(ws + WS_HB), (size_t)256 * 1024 * 2, (const char*)(ws + WS_WTIN) + (size_t)l * INWP * 1024 * 2, (size_t)256 * 1024 * 2, MR / 256, INWP / 256, G, bid, 0};
            EpiNone E{(float*)(ws + WS_GWS)};
            pg8::gemm_phase(ldsl, 1024, 1024, S, E, wid_s);
        }
        if (DUP & 4096) {
            pg8::SchedDense S{(const char*)(ws + WS_HB), (size_t)256 * 1024 * 2, (const char*)(ws + WS_WTIN) + (size_t)l * INWP * 1024 * 2, (size_t)256 * 1024 * 2, MR / 256, INWP / 256, G, bid, 2};
            EpiNone E{(float*)(ws + WS_GWS)};
            pg8::gemm_phase(ldsl, 1024, 1024, S, E, wid_s);
        }
        gsync(gbar, ++gep, wid_s);
        REP(6) if (PH & 8) rowa_phase(a, l, wid_s);
        gsync(gbar, ++gep, wid_s);
        if (PH & 16) {
            const bool lastl = (l == DEPTH - 1);
            pg8::SchedQKV S{(const char*)(ws + WS_P), (const char*)(ws + WS_WTUQ) + (size_t)l * 768 * 256 * 2, (const char*)(ws + WS_P) + OFF_KV * 2, (const char*)(ws + WS_WTUKV) + (size_t)l * 1024 * 256 * 2,
                            (size_t)256 * INWP * 2, (size_t)256 * 256 * 2, lastl ? 128 : MR / 256, lastl ? 1 : 0, G, bid};
            EpiQKV E{EpiQ{(bf16_t*)(ws + WS_Q), (const float*)(ws + WS_RSQ), (const float2*)(ws + WS_ROPE)}, EpiKV{(bf16_t*)(ws + WS_KN), (bf16_t*)(ws + WS_VT), (const float*)(ws + WS_RSKV)}};
            pg8::gemm_phase(ldsl, 256, INWP, S, E, wid_s);
        }
        gsync(gbar, ++gep, wid_s);
        if (PH & 64) attn_phase<0>(a, l < DEPTH - 1, ldsl, wid_s);
        if (DUP & 1) attn_phase<AMODE>(a, l < DEPTH - 1, ldsl, wid_s);
        gsync(gbar, ++gep, wid_s);
        REP(5) {
        if (PH & 128) {
            pg8::SchedDense S{(const char*)(ws + WS_AC), (size_t)256 * 1024 * 2, (const char*)(ws + WS_WTOAB) + (size_t)l * 1024 * 1024 * 2, (size_t)256 * 512 * 2, (l == DEPTH - 1) ? 128 : MR / 256, 4, G, bid, (l == DEPTH - 1) ? 1 : 0};
            EpiMergeA E{(bf16_t*)(ws + WS_MG), (const bf16_t*)(ws + WS_P)};
            pg8::gemm_phase(ldsl, 512, 1024, S, E, wid_s);
        }
        if (PH & 128) {
            pg8::SchedDense S{(const char*)(ws + WS_AC) + 512 * 2, (size_t)256 * 1024 * 2, (const char*)(ws + WS_WTOAB) + (size_t)l * 1024 * 1024 * 2 + (size_t)1024 * 512 * 2, (size_t)256 * 512 * 2, (l == DEPTH - 1) ? 128 : MR / 256, 4, G, bid, (l == DEPTH - 1) ? 1 : 0};
            EpiMergeB E{(bf16_t*)(ws + WS_MG), (const bf16_t*)(ws + WS_P)};
            pg8::gemm_phase(ldsl, 512, 1024, S, E, wid_s);
        }
        }
        gsync(gbar, ++gep, wid_s);
        for (int rep_ = 0; rep_ <= (((DUP >> 8) & 1) && l == 0 ? 1 : 0); ++rep_) if (PH & 256) {
            pg8::SchedDense S{(const char*)(ws + WS_MG), (size_t)256 * 1024 * 2, (const char*)(ws + WS_WTO) + (size_t)l * 1024 * 1024 * 2, (size_t)256 * 1024 * 2, (l == DEPTH - 1) ? 128 : MR / 256, 4, G, bid, (l == DEPTH - 1) ? 1 : 0};
            EpiOut E{(float*)(ws + WS_RES), a.in[0], a.in[2], (const float*)(ws + WS_MOD) + (size_t)l * 5 * 6144, l};
            pg8::gemm_phase(ldsl, 1024, 1024, S, E, wid_s);
        }
        gsync(gbar, ++gep, wid_s);
        if (PH & 512) ln1_router_phase(a, l, lds, wid_s);
        gsync(gbar, ++gep, wid_s);
        REP(6) if (PH & 1024) gather_phase(a, l, lds, wid_s);
        gsync(gbar, ++gep, wid_s);
        REP(1) if (PH & 2048) {
            moe_prefix(a, l, lds, wid_s);
            const LAS int* ts = (const LAS int*)(ldsl + MISC_OFF);
            const int TM = ts[32];
            pg8::SchedMoe S{(const char*)(ws + WS_HB), (size_t)0, (const char*)(ws + WS_WTGU) + (size_t)l * NEXP * 2048 * 1024 * 2, (size_t)2048 * 1024 * 2, (size_t)256 * 1024 * 2, TM, 8, G, bid, ts};
            EpiGU E{(bf16_t*)(ws + WS_ACT), a.in[25] + (size_t)l * NEXP * 2048};
            {
                const int tid = mk_tid(wid_s); const int* RO = (const int*)(ws + WS_ROWOFF); LAS int* tab = (LAS int*)(ldsl + GTAB_OFF);
                pg8::Unit uu;
                for (int i = 0; i < 27 && S.next(i, uu); ++i) if (tid < 256) tab[i * 256 + tid] = RO[uu.pm * 256 + tid];
                __syncthreads();
            }
            pg8::gemm_phase<EpiGU, pg8::SchedMoe, true>(ldsl, 1024, 1024, S, E, wid_s, (const LAS int*)(ldsl + GTAB_OFF));
        }
        gsync(gbar, ++gep, wid_s);
        REP(1) if (PH & 4096) {
            const LAS int* ts = (const LAS int*)(ldsl + MISC_OFF);
            const int TM = ts[32];
            pg8::SchedMoe S{(const char*)(ws + WS_ACT), (size_t)256 * 1024 * 2, (const char*)(ws + WS_WTDN) + (size_t)l * NEXP * 1024 * 1024 * 2, (size_t)1024 * 1024 * 2, (size_t)256 * 1024 * 2, TM, 4, G, bid, ts};
            EpiDown E{(bf16_t*)(ws + WS_AS), a.in[27] + (size_t)l * NEXP * 1024, (const float*)(ws + WS_GWS)};
            pg8::gemm_phase(ldsl, 1024, 1024, S, E, wid_s);
        }
        gsync(gbar, ++gep, wid_s);
        for (int rep_ = 0; rep_ <= (((DUP >> 9) & 1) && l == DEPTH - 1 ? 1 : 0); ++rep_) if (PH & 8192) ln2_phase(a, l, wid_s);
        if (l + 1 < DEPTH) gsync(gbar, ++gep, wid_s);
    }
}

extern "C" void kernel_launch(void* const* d_in, const int* in_sizes, int n_in, void* d_out, int out_size, void* d_ws, size_t ws_size, hipStream_t stream) {
    static int grid = 0;
    if (grid == 0) {
        int dev = 0, cus = 0, per_cu = 0;
        if (hipGetDevice(&dev) != hipSuccess || hipDeviceGetAttribute(&cus, hipDeviceAttributeMultiprocessorCount, dev) != hipSuccess) { fprintf(stderr, "kernel_launch: device query failed\n"); grid = -1; return; }
        if (n_in != 28 || ws_size < WS_END) { fprintf(stderr, "kernel_launch: need 28 inputs and %zu B workspace; got %d, %zu\n", (size_t)WS_END, n_in, ws_size); grid = -1; return; }
        if (hipFuncSetAttribute((const void*)mk_fwd, hipFuncAttributeMaxDynamicSharedMemorySize, LDS_BYTES) != hipSuccess) { fprintf(stderr, "kernel_launch: hipFuncSetAttribute failed\n"); grid = -1; return; }
        if (hipOccupancyMaxActiveBlocksPerMultiprocessor(&per_cu, (const void*)mk_fwd, NTHREADS, LDS_BYTES) != hipSuccess || per_cu < 1) { fprintf(stderr, "kernel_launch: occupancy query says %d\n", per_cu); per_cu = 1; }
        (void)hipGetLastError();
        grid = cus;
        if (grid > 256) grid = 256;
        grid &= ~7;
    }
    if (grid <= 0) return;
    Args a{};
    for (int i = 0; i < 28; ++i) a.in[i] = (const float*)d_in[i];
    a.out = (float*)d_out; a.ws = (unsigned char*)d_ws;
    void* args[] = {&a};
    hipError_t e = hipLaunchCooperativeKernel((const void*)mk_fwd, dim3(grid), dim3(NTHREADS), args, LDS_BYTES, stream);
    if (e != hipSuccess) fprintf(stderr, "kernel_launch: cooperative launch failed: %s (grid %d)\n", hipGetErrorString(e), grid);
}
```
